# Optimizing an MI355X kernel written in HIP

```python
import math
import jax, jax.numpy as jnp
from jax import lax
import numpy as np

D_MODEL = 1024
BATCH = 32
SEQ = 256
DEPTH = 2
DEC_BATCH = 4
DEC_SEQ = 4096
PAST_LEN = 512

GRID_W = 64
N_MIXERS = 4
GROUP_WIDTH = D_MODEL // N_MIXERS
HEAD_DIM = 64
N_HEADS = GROUP_WIDTH // HEAD_DIM
WIN_KV_HEADS = 2
WIN_GROUPS = N_HEADS // WIN_KV_HEADS
WINDOW = 128
WIN_BLOCK = 128
Q_BLOCK = 128
DIFF_DIM = HEAD_DIM // 2
REC_CHUNK = 16
FFN_HIDDEN = ((8 * D_MODEL // 3 + 255) // 256) * 256
ROPE_BASE = 10000.0
EPS = 1e-6
MASK_VALUE = -1e30
SPLIT_SIZES = ((GROUP_WIDTH,) * 4
               + (GROUP_WIDTH, WIN_KV_HEADS * HEAD_DIM, WIN_KV_HEADS * HEAD_DIM)
               + (GROUP_WIDTH,) * 3
               + (GROUP_WIDTH,) * 5)
IN_WIDTH = sum(SPLIT_SIZES)
SPLIT_POINTS = tuple(int(s) for s in np.cumsum(SPLIT_SIZES)[:-1])

kernel_name = 'hybrid_prefix_diffusion_step'

F32 = jnp.float32


def rmsnorm(x, g):
    xf = x.astype(F32)
    y = xf * lax.rsqrt(jnp.mean(xf * xf, axis=-1, keepdims=True) + EPS)
    return (y * g.astype(F32)).astype(x.dtype)


def rope_axis(x, pos):
    half = x.shape[-1] // 2
    inv = ROPE_BASE ** (-jnp.arange(half, dtype=F32) / half)
    ang = pos.astype(F32)[:, None] * inv[None, :]
    cos, sin = jnp.cos(ang), jnp.sin(ang)
    xf = x.astype(F32)
    x1, x2 = xf[..., :half], xf[..., half:]
    return jnp.concatenate([x1 * cos - x2 * sin, x2 * cos + x1 * sin], axis=-1).astype(x.dtype)


def rope_2d(x, row, col):
    d = x.shape[-1] // 2
    return jnp.concatenate([rope_axis(x[..., :d], row), rope_axis(x[..., d:], col)], axis=-1)


def grid_positions(n_tokens):
    n_rows = n_tokens // GRID_W
    row = jnp.repeat(jnp.arange(n_rows), GRID_W)
    col = jnp.tile(jnp.arange(GRID_W), n_rows)
    return row, col


def split_heads(x, n):
    b, l, _ = x.shape
    return x.reshape(b, l, n, -1).transpose(0, 2, 1, 3)


def merge_heads(x):
    b, n, l, d = x.shape
    return x.transpose(0, 2, 1, 3).reshape(b, l, n * d)


def chunk_recurrence(q, k, v, log_f, s0):
    b, h, l, dk = q.shape
    dv = v.shape[-1]
    n = l // REC_CHUNK
    shp = lambda a: a.astype(F32).reshape(b, h, n, REC_CHUNK, a.shape[-1])
    qc, kc, vc, lf = shp(q), shp(k), shp(v), shp(log_f)
    cum = jnp.cumsum(lf, axis=3)
    last = cum[:, :, :, -1:, :]
    causal = jnp.tril(jnp.ones((REC_CHUNK, REC_CHUNK), bool))[:, :, None]
    rel = cum[:, :, :, :, None, :] - cum[:, :, :, None, :, :]
    decay = jnp.where(causal, jnp.exp(jnp.where(causal, rel, 0.0)), 0.0)
    attn = jnp.einsum('bhntd,bhnsd,bhntsd->bhnts', qc, kc, decay)
    o_intra = jnp.einsum('bhnts,bhnsv->bhntv', attn, vc)
    u = jnp.einsum('bhnsd,bhnsv->bhndv', kc * jnp.exp(last - cum), vc)
    dec = jnp.exp(last[:, :, :, 0])

    def step(s, inp):
        d_n, u_n = inp
        return d_n[..., None] * s + u_n, s

    s_fin, s_in = lax.scan(step, s0.astype(F32), (jnp.moveaxis(dec, 2, 0), jnp.moveaxis(u, 2, 0)))
    s_in = jnp.moveaxis(s_in, 0, 2)
    o_inter = jnp.einsum('bhntd,bhndv->bhntv', qc * jnp.exp(cum), s_in)
    o = (o_intra + o_inter).reshape(b, h, l, dv).astype(v.dtype)
    return o, s_fin.astype(v.dtype)


def bidir_recurrence(q, k_f, k_b, v, lf_f, lf_b, s0_f, s0_b):
    flip = lambda a: jnp.flip(a, axis=2)
    o_f, s_f = chunk_recurrence(q, k_f, v, lf_f, s0_f)
    o_b, s_b = chunk_recurrence(flip(q), flip(k_b), flip(v), flip(lf_b), s0_b)
    return o_f + flip(o_b), jnp.stack([s_f, s_b], axis=1)


def block_attention(q, k, v, sink=None):
    b, hk, g, lq, d = q.shape
    nb = lq // Q_BLOCK
    qb = jnp.moveaxis(q.reshape(b, hk, g, nb, Q_BLOCK, d), 3, 0)
    kf = k.astype(F32)
    scale = d ** -0.5

    def attend(qi):
        s = jnp.einsum('bhgqd,bhkd->bhgqk', qi.astype(F32), kf) * scale
        if sink is not None:
            s_sink = jnp.broadcast_to(sink.astype(F32)[None, :, :, None, None], s.shape[:-1] + (1,))
            p = jax.nn.softmax(jnp.concatenate([s_sink, s], axis=-1), axis=-1)[..., 1:]
        else:
            p = jax.nn.softmax(s, axis=-1)
        return jnp.einsum('bhgqk,bhkv->bhgqv', p.astype(v.dtype), v)

    o = lax.map(attend, qb)
    return jnp.moveaxis(o, 0, 3).reshape(b, hk, g, lq, v.shape[-1])


def window_attention(q, k, v, k_ctx, v_ctx, sink):
    b, hk, g, l, d = q.shape
    nb = l // WIN_BLOCK
    pad = ((0, 0), (0, 0), (WIN_BLOCK, WIN_BLOCK), (0, 0))

    def bands(a):
        ap = jnp.pad(a, pad).reshape(b, hk, nb + 2, WIN_BLOCK, a.shape[-1])
        return jnp.concatenate([ap[:, :, :-2], ap[:, :, 1:-1], ap[:, :, 2:]], axis=3)

    kb, vb = bands(k), bands(v)
    qb = q.reshape(b, hk, g, nb, WIN_BLOCK, d).astype(F32)
    scale = d ** -0.5
    s_loc = jnp.einsum('bhgnqd,bhnkd->bhgnqk', qb, kb.astype(F32)) * scale
    q_pos = jnp.arange(l).reshape(nb, WIN_BLOCK)
    k_pos = (jnp.arange(nb)[:, None] - 1) * WIN_BLOCK + jnp.arange(3 * WIN_BLOCK)[None, :]
    valid = ((k_pos[:, None, :] >= 0) & (k_pos[:, None, :] < l)
             & (jnp.abs(q_pos[:, :, None] - k_pos[:, None, :]) <= WINDOW))
    s_loc = jnp.where(valid, s_loc, MASK_VALUE)
    s_ctx = jnp.einsum('bhgnqd,bhkd->bhgnqk', qb, k_ctx.astype(F32)) * scale
    s_sink = jnp.broadcast_to(sink.astype(F32)[None, :, :, None, None, None], s_loc.shape[:-1] + (1,))
    probs = jax.nn.softmax(jnp.concatenate([s_sink, s_loc, s_ctx], axis=-1), axis=-1)
    n_loc = 3 * WIN_BLOCK
    p_loc = jnp.where(valid, probs[..., 1:1 + n_loc], 0.0).astype(v.dtype)
    p_ctx = probs[..., 1 + n_loc:].astype(v.dtype)
    o = (jnp.einsum('bhgnqk,bhnkv->bhgnqv', p_loc, vb)
         + jnp.einsum('bhgnqk,bhkv->bhgnqv', p_ctx, v_ctx.astype(v.dtype)))
    return o.reshape(b, hk, g, l, -1)


def hgrn_gate(z, lb):
    lbh = lb.astype(F32).reshape(N_HEADS, 1, HEAD_DIM)
    zf = z.astype(F32)
    f = lbh + (1.0 - lbh) * jax.nn.sigmoid(zf)
    log_f = jnp.log(jnp.maximum(f, 1e-30))
    k = (1.0 - lbh) * jax.nn.sigmoid(-zf)
    return log_f, k


def token_mixing(h, p, lam_init, lb, ctx, pos):
    b, l, _ = h.shape
    latent = ctx is not None
    (rq, rk, rv, rg, wq, wk, wv, dq, dk, dv, hq, hzf, hzb, hi, hg) = jnp.split(
        h @ p['w_in'], SPLIT_POINTS, axis=-1)

    rq = split_heads(rq, N_HEADS)
    rk = split_heads(rk, N_HEADS) * (HEAD_DIM ** -0.5)
    rv = split_heads(rv, N_HEADS)
    if latent:
        rq, rk = rope_2d(rq, *pos), rope_2d(rk, *pos)
    log_gamma = -jnp.exp(p['ret_decay'].astype(F32))
    lg_f = jnp.broadcast_to(log_gamma[0][None, :, None, None], rq.shape)
    lg_b = jnp.broadcast_to(log_gamma[1][None, :, None, None], rq.shape)
    s0 = ctx['ret'] if latent else jnp.zeros((b, 2, N_HEADS, HEAD_DIM, HEAD_DIM), F32)
    o_ret, st_ret = bidir_recurrence(rq, rk, rk, rv, lg_f, lg_b, s0[:, 0], s0[:, 1])
    o_ret = merge_heads(rmsnorm(o_ret, p['ret_norm'].reshape(N_HEADS, 1, HEAD_DIM))) * jax.nn.silu(rg)

    wq = rmsnorm(split_heads(wq, N_HEADS), p['win_qn'])
    wk = rmsnorm(split_heads(wk, WIN_KV_HEADS), p['win_kn'])
    wv = split_heads(wv, WIN_KV_HEADS)
    sink = p['win_sink'].reshape(WIN_KV_HEADS, WIN_GROUPS)
    if latent:
        wq, wk = rope_2d(wq, *pos), rope_2d(wk, *pos)
        o_win = window_attention(wq.reshape(b, WIN_KV_HEADS, WIN_GROUPS, l, HEAD_DIM), wk, wv,
                                 ctx['win_k'], ctx['win_v'], sink)
    else:
        o_win = block_attention(wq.reshape(b, WIN_KV_HEADS, WIN_GROUPS, l, HEAD_DIM), wk, wv, sink)
    o_win = merge_heads(o_win.reshape(b, N_HEADS, l, HEAD_DIM))

    dq = rmsnorm(dq.reshape(b, l, N_HEADS, 2, DIFF_DIM).transpose(0, 2, 3, 1, 4), p['diff_qn'])
    dk = rmsnorm(dk.reshape(b, l, N_HEADS, 2, DIFF_DIM).transpose(0, 2, 3, 1, 4), p['diff_kn'])
    dv = split_heads(dv, N_HEADS)
    if latent:
        dq, dk = rope_2d(dq, *pos), rope_2d(dk, *pos)
        keys = jnp.concatenate([dk, ctx['diff_k'].astype(dk.dtype)], axis=3)
        vals = jnp.concatenate([dv, ctx['diff_v'].astype(dv.dtype)], axis=2)
    else:
        keys, vals = dk, dv
    o1 = block_attention(dq[:, :, 0:1], keys[:, :, 0], vals)
    o2 = block_attention(dq[:, :, 1:2], keys[:, :, 1], vals)
    lq1, lk1, lq2, lk2 = p['diff_lambda'].astype(F32)
    lam = jnp.exp(jnp.sum(lq1 * lk1)) - jnp.exp(jnp.sum(lq2 * lk2)) + lam_init
    o_diff = (o1[:, :, 0].astype(F32) - lam * o2[:, :, 0].astype(F32)).astype(h.dtype)
    o_diff = merge_heads(rmsnorm(o_diff, p['diff_norm'].reshape(N_HEADS, 1, HEAD_DIM))) * (1.0 - lam_init)

    hq = split_heads(hq, N_HEADS)
    hi = split_heads(hi, N_HEADS)
    lf_f, k_f = hgrn_gate(split_heads(hzf, N_HEADS), lb[0])
    lf_b, k_b = hgrn_gate(split_heads(hzb, N_HEADS), lb[1])
    s0 = ctx['hgrn'] if latent else jnp.zeros((b, 2, N_HEADS, HEAD_DIM, HEAD_DIM), F32)
    o_h, st_h = bidir_recurrence(hq, k_f, k_b, hi, lf_f, lf_b, s0[:, 0], s0[:, 1])
    o_h = merge_heads(rmsnorm(o_h, p['hgrn_norm'].reshape(N_HEADS, 1, HEAD_DIM))) * jax.nn.silu(hg)

    out = jnp.concatenate([o_ret, o_win, o_diff, o_h], axis=-1) @ p['w_out']
    new = None if latent else dict(ret=st_ret, win_k=wk, win_v=wv, diff_k=dk, diff_v=dv, hgrn=st_h)
    return out, new


def trunk_layer(x, cond, p, lam_init, lb, ctx, pos):
    mod = (jax.nn.silu(cond) @ p['w_ada'] + p['b_ada']).reshape(cond.shape[0], 6, 1, D_MODEL)
    sh1, sc1, g1, sh2, sc2, g2 = [mod[:, i] for i in range(6)]
    h = rmsnorm(x, p['norm1']) * (1.0 + sc1) + sh1
    mix, new = token_mixing(h, p, lam_init, lb, ctx, pos)
    x = x + g1 * mix
    h = rmsnorm(x, p['norm2']) * (1.0 + sc2) + sh2
    gate, up = jnp.split(h @ p['w_ffn_in'], 2, axis=-1)
    x = x + g2 * ((jax.nn.silu(gate) * up) @ p['w_ffn_out'])
    return x, new


def setup_inputs(seed: int = 0) -> dict:
    key = jax.random.key(seed)
    ks = iter(jax.random.split(key, 40))
    nrm = lambda shape, s: s * jax.random.normal(next(ks), shape, F32)
    gain = lambda shape: 1.0 + nrm(shape, 0.05)
    ret_base = jnp.asarray(np.log(-np.log(1.0 - 2.0 ** (-5.0 - np.arange(N_HEADS)))), F32)
    return {
        'x_prompt': nrm((BATCH, SEQ, D_MODEL), 1.0),
        'x_sample': nrm((DEC_BATCH, DEC_SEQ, D_MODEL), 1.0),
        'state_ret': nrm((DEC_BATCH, DEPTH, 2, N_HEADS, HEAD_DIM, HEAD_DIM), 0.3),
        'cache_win_k': nrm((DEC_BATCH, DEPTH, WIN_KV_HEADS, PAST_LEN, HEAD_DIM), 1.0),
        'cache_win_v': nrm((DEC_BATCH, DEPTH, WIN_KV_HEADS, PAST_LEN, HEAD_DIM), 1.0),
        'cache_diff_k': nrm((DEC_BATCH, DEPTH, N_HEADS, 2, PAST_LEN, DIFF_DIM), 1.0),
        'cache_diff_v': nrm((DEC_BATCH, DEPTH, N_HEADS, PAST_LEN, HEAD_DIM), 1.0),
        'state_hgrn': nrm((DEC_BATCH, DEPTH, 2, N_HEADS, HEAD_DIM, HEAD_DIM), 0.3),
        'c': nrm((DEC_BATCH, D_MODEL), 1.0),
        'c_ctx': nrm((D_MODEL,), 1.0),
        'norm1_g': gain((DEPTH, D_MODEL)),
        'norm2_g': gain((DEPTH, D_MODEL)),
        'w_ada': nrm((DEPTH, D_MODEL, 6 * D_MODEL), 0.5 * D_MODEL ** -0.5),
        'b_ada': nrm((DEPTH, 6 * D_MODEL), 0.01),
        'w_in': nrm((DEPTH, D_MODEL, IN_WIDTH), D_MODEL ** -0.5),
        'ret_decay': ret_base[None, None, :] + nrm((DEPTH, 2, N_HEADS), 0.05),
        'ret_norm_g': gain((DEPTH, GROUP_WIDTH)),
        'win_q_norm': gain((DEPTH, HEAD_DIM)),
        'win_k_norm': gain((DEPTH, HEAD_DIM)),
        'win_sink': nrm((DEPTH, N_HEADS), 0.5),
        'diff_q_norm': gain((DEPTH, DIFF_DIM)),
        'diff_k_norm': gain((DEPTH, DIFF_DIM)),
        'diff_lambda': nrm((DEPTH, 4, DIFF_DIM), 0.1),
        'diff_norm_g': gain((DEPTH, GROUP_WIDTH)),
        'hgrn_lb_logits': nrm((DEPTH, 2, GROUP_WIDTH), 0.5),
        'hgrn_norm_g': gain((DEPTH, GROUP_WIDTH)),
        'w_out': nrm((DEPTH, D_MODEL, D_MODEL), D_MODEL ** -0.5),
        'w_ffn_in': nrm((DEPTH, D_MODEL, 2 * FFN_HIDDEN), D_MODEL ** -0.5),
        'w_ffn_out': nrm((DEPTH, FFN_HIDDEN, D_MODEL), FFN_HIDDEN ** -0.5),
    }


def reference(x_prompt, x_sample, state_ret, cache_win_k, cache_win_v, cache_diff_k, cache_diff_v,
              state_hgrn, c, c_ctx, norm1_g, norm2_g, w_ada, b_ada, w_in, ret_decay, ret_norm_g,
              win_q_norm, win_k_norm, win_sink, diff_q_norm, diff_k_norm, diff_lambda, diff_norm_g,
              hgrn_lb_logits, hgrn_norm_g, w_out, w_ffn_in, w_ffn_out):
    lb_p = jax.nn.softmax(hgrn_lb_logits.astype(F32), axis=0)
    lb_all = jnp.cumsum(lb_p, axis=0) - lb_p
    pos = grid_positions(x_sample.shape[1])
    y_p, y_s = x_prompt, x_sample
    n_ret, n_wk, n_wv, n_dk, n_dv, n_hg = [], [], [], [], [], []
    for l in range(DEPTH):
        p = dict(norm1=norm1_g[l], norm2=norm2_g[l], w_ada=w_ada[l], b_ada=b_ada[l], w_in=w_in[l],
                 ret_decay=ret_decay[l], ret_norm=ret_norm_g[l], win_qn=win_q_norm[l],
                 win_kn=win_k_norm[l], win_sink=win_sink[l], diff_qn=diff_q_norm[l],
                 diff_kn=diff_k_norm[l], diff_lambda=diff_lambda[l], diff_norm=diff_norm_g[l],
                 hgrn_norm=hgrn_norm_g[l], w_out=w_out[l], w_ffn_in=w_ffn_in[l], w_ffn_out=w_ffn_out[l])
        lam_init = 0.8 - 0.6 * math.exp(-0.3 * l)
        y_p, st = trunk_layer(y_p, c_ctx[None, :], p, lam_init, lb_all[l], None, None)
        n_ret.append(st['ret']); n_wk.append(st['win_k']); n_wv.append(st['win_v'])
        n_dk.append(st['diff_k']); n_dv.append(st['diff_v']); n_hg.append(st['hgrn'])
        ctx = dict(ret=state_ret[:, l], win_k=cache_win_k[:, l], win_v=cache_win_v[:, l],
                   diff_k=cache_diff_k[:, l], diff_v=cache_diff_v[:, l], hgrn=state_hgrn[:, l])
        y_s, _ = trunk_layer(y_s, c, p, lam_init, lb_all[l], ctx, pos)
    return (y_p, y_s, jnp.stack(n_ret, axis=1), jnp.stack(n_wk, axis=1), jnp.stack(n_wv, axis=1),
            jnp.stack(n_dk, axis=1), jnp.stack(n_dv, axis=1), jnp.stack(n_hg, axis=1))
```

```cpp
#include <hip/hip_runtime.h>
#include <hip/hip_cooperative_groups.h>
#include <cstdio>
namespace cg = cooperative_groups;

typedef unsigned short u16;
typedef __attribute__((ext_vector_type(8))) short bf16x8;
typedef __attribute__((ext_vector_type(4))) short s16x4;
typedef __attribute__((ext_vector_type(4))) float f32x4;
#define DI __device__ __forceinline__
#define MFMA(a, b, c) __builtin_amdgcn_mfma_f32_16x16x32_bf16((a), (b), (c), 0, 0, 0)

constexpr int NPT = 8192;
constexpr int GT = 12288;
constexpr int NGROUP = 2;
constexpr int PW = 2176;
constexpr int NCH = GT / 64;
constexpr float EPS = 1e-6f;
constexpr float LOG2E = 1.4426950408889634f;

constexpr int PC_RQ = 0, PC_RK = 256, PC_RG = 512, PC_WQ = 768, PC_WK = 1024, PC_DQ = 1152, PC_DK = 1408, PC_HQ = 1664, PC_HG = 1920;
constexpr int VH_RET = 0, VH_WIN = 4, VH_DIFF = 6, VH_HGRN = 10;

constexpr size_t OFF_MOD = 16384;
constexpr size_t OFF_ROPEA = OFF_MOD + 2 * 5 * 6144 * 4;
constexpr size_t OFF_ROPEB = OFF_ROPEA + 64 * 16 * 8;
constexpr size_t OFF_WIN = OFF_ROPEB + 64 * 8 * 8;
constexpr size_t OFF_WOUT = OFF_WIN + (size_t)2 * 3584 * 1024 * 2;
constexpr size_t OFF_WFI = OFF_WOUT + (size_t)2 * 1024 * 1024 * 2;
constexpr size_t OFF_WFO = OFF_WFI + (size_t)2 * 5632 * 1024 * 2;
constexpr size_t OFF_CWK = OFF_WFO + (size_t)2 * 1024 * 2816 * 2;
constexpr size_t OFF_CWVT = OFF_CWK + (size_t)2 * 4 * 2 * 512 * 64 * 2;
constexpr size_t OFF_CDK = OFF_CWVT + (size_t)2 * 4 * 2 * 512 * 64 * 2;
constexpr size_t OFF_CDVT = OFF_CDK + (size_t)2 * 4 * 4 * 2 * 512 * 32 * 2;
constexpr size_t OFF_HB = OFF_CDVT + (size_t)2 * 4 * 4 * 64 * 512 * 2;
constexpr size_t OFF_PB = OFF_HB + (size_t)GT * 1024 * 2;
constexpr size_t OFF_VT = OFF_PB + (size_t)GT * 2816 * 2;
constexpr size_t OFF_LF = OFF_VT + (size_t)14 * 64 * GT * 2;
constexpr size_t OFF_ST = OFF_LF + (size_t)2 * GT * 256 * 4;
constexpr size_t OFF_DEC = OFF_ST + (size_t)2 * NCH * 2 * 4 * 4096 * 4;
constexpr size_t WS_TOTAL = OFF_DEC + (size_t)2 * NCH * 2 * 4 * 64 * 4;

constexpr size_t O_SRET = 25165824, O_CWK = 27262976, O_CWV = 29360128, O_CDK = 31457280, O_CDV = 35651584, O_SHG = 39845888;

struct Params {
  const float *x_prompt, *x_sample, *state_ret, *cwk, *cwv, *cdk, *cdv, *state_hgrn, *c, *c_ctx, *norm1_g, *norm2_g, *w_ada, *b_ada,
      *w_in, *ret_decay, *ret_norm_g, *win_q_norm, *win_k_norm, *win_sink, *diff_q_norm, *diff_k_norm, *diff_lambda, *diff_norm_g,
      *hgrn_lb, *hgrn_norm_g, *w_out, *w_ffn_in, *w_ffn_out;
  float* out;
  char* ws;
};

DI u16 f2bf(float x) { unsigned u = __float_as_uint(x); u += 0x7fffu + ((u >> 16) & 1u); return (u16)(u >> 16); }
DI float bf2f(u16 h) { return __uint_as_float(((unsigned)h) << 16); }
DI unsigned pack2(float a, float b) { return (unsigned)f2bf(a) | ((unsigned)f2bf(b) << 16); }
DI float silu(float x) { return x / (1.f + __expf(-x)); }
DI int get_tid() { int t = threadIdx.x; asm volatile("" : "+v"(t)); return t; }
DI int cond_of(int gtok) { return gtok < NPT ? 0 : 1 + ((gtok - NPT) >> 12); }

template <class RM>
DI void transpose_tile(const float* __restrict__ src, size_t ld_src, u16* __restrict__ dst, size_t ld_dst, float* sm, RM rowmap) {
  const int tid = get_tid();
#pragma unroll
  for (int i = 0; i < 16; ++i) { int e = tid + 256 * i; int r = e >> 6, c = e & 63; sm[r * 65 + c] = src[(size_t)r * ld_src + c]; }
  __syncthreads();
#pragma unroll
  for (int i = 0; i < 16; ++i) { int e = tid + 256 * i; int c = e >> 6, r = e & 63; dst[(size_t)rowmap(c) * ld_dst + r] = f2bf(sm[r * 65 + c]); }
  __syncthreads();
}

DI void prep_phase(const Params& P, char* smem) {
  float* sm = (float*)smem;
  const int tid = get_tid();
  constexpr int PER_L = 896 + 256 + 1408 + 704;
  constexpr int N_W = 2 * PER_L;
  constexpr int N_CWV = 128, N_CDV = 256, N_MOD = 192;
  constexpr int TOTAL = N_W + N_CWV + N_CDV + N_MOD + 1;
  for (int it = blockIdx.x; it < TOTAL; it += gridDim.x) {
    if (it < N_W) {
      int l = it / PER_L, r = it % PER_L;
      if (r < 896) {
        int kt = r / 56, nt = r % 56;
        const float* src = P.w_in + (size_t)l * 1024 * 3584 + (size_t)kt * 64 * 3584 + nt * 64;
        u16* dst = (u16*)(P.ws + OFF_WIN) + (size_t)l * 3584 * 1024 + kt * 64;
        int nb = nt * 64;
        transpose_tile(src, 3584, dst, 1024, sm, [nb](int c) { return nb + c; });
      } else if (r < 1152) {
        r -= 896; int kt = r / 16, nt = r % 16;
        const float* src = P.w_out + (size_t)l * 1024 * 1024 + (size_t)kt * 64 * 1024 + nt * 64;
        u16* dst = (u16*)(P.ws + OFF_WOUT) + (size_t)l * 1024 * 1024 + kt * 64;
        int nb = nt * 64;
        transpose_tile(src, 1024, dst, 1024, sm, [nb](int c) { return nb + c; });
      } else if (r < 2560) {
        r -= 1152; int kt = r / 88, nt = r % 88;
        const float* src = P.w_ffn_in + (size_t)l * 1024 * 5632 + (size_t)kt * 64 * 5632 + nt * 64;
        u16* dst = (u16*)(P.ws + OFF_WFI) + (size_t)l * 5632 * 1024 + kt * 64;
        int nb = nt * 64;
        transpose_tile(src, 5632, dst, 1024, sm, [nb](int c) { int n = nb + c; int s = n >= 2816 ? 1 : 0; int jn = n - s * 2816; return 32 * (jn >> 4) + 16 * s + (jn & 15); });
      } else {
        r -= 2560; int kt = r / 16, nt = r % 16;
        const float* src = P.w_ffn_out + (size_t)l * 2816 * 1024 + (size_t)kt * 64 * 1024 + nt * 64;
        u16* dst = (u16*)(P.ws + OFF_WFO) + (size_t)l * 1024 * 2816 + kt * 64;
        int nb = nt * 64;
        transpose_tile(src, 1024, dst, 2816, sm, [nb](int c) { return nb + c; });
      }
    } else if (it < N_W + N_CWV) {
      int r = it - N_W; int mat = r >> 3, kt = r & 7;
      const float* src = P.cwv + (size_t)mat * 512 * 64 + (size_t)kt * 64 * 64;
      const int dm = (((mat >> 1) & 1) * 4 + (mat >> 2)) * 2 + (mat & 1);
      u16* dst = (u16*)(P.ws + OFF_CWVT) + (size_t)dm * 64 * 512 + kt * 64;
      transpose_tile(src, 64, dst, 512, sm, [](int c) { return c; });
    } else if (it < N_W + N_CWV + N_CDV) {
      int r = it - N_W - N_CWV; int mat = r >> 3, kt = r & 7;
      const float* src = P.cdv + (size_t)mat * 512 * 64 + (size_t)kt * 64 * 64;
      const int dm = (((mat >> 2) & 1) * 4 + (mat >> 3)) * 4 + (mat & 3);
      u16* dst = (u16*)(P.ws + OFF_CDVT) + (size_t)dm * 64 * 512 + kt * 64;
      transpose_tile(src, 64, dst, 512, sm, [](int c) { return c; });
    } else if (it < N_W + N_CWV + N_CDV + N_MOD) {
      int r = it - N_W - N_CWV - N_CDV; int l = r / 96, cb = r % 96;
      for (int e = tid; e < 5 * 1024; e += 256) { int j = e >> 10, k = e & 1023; float v = (j == 0) ? P.c_ctx[k] : P.c[(j - 1) * 1024 + k]; sm[e] = silu(v); }
      __syncthreads();
      const int w = tid >> 6, lane = tid & 63; const int col = cb * 64 + lane;
      float acc[5] = {0.f, 0.f, 0.f, 0.f, 0.f};
      const float* wp = P.w_ada + (size_t)l * 1024 * 6144 + col;
#pragma unroll 8
      for (int k = w * 256; k < w * 256 + 256; ++k) {
        float wv = wp[(size_t)k * 6144];
#pragma unroll
        for (int j = 0; j < 5; ++j) acc[j] += sm[j * 1024 + k] * wv;
      }
      float* red = sm + 5 * 1024;
#pragma unroll
      for (int j = 0; j < 5; ++j) red[(w * 5 + j) * 64 + lane] = acc[j];
      __syncthreads();
      if (w == 0) {
        float* mod = (float*)(P.ws + OFF_MOD);
#pragma unroll
        for (int j = 0; j < 5; ++j) {
          float s = red[(0 * 5 + j) * 64 + lane] + red[(1 * 5 + j) * 64 + lane] + red[(2 * 5 + j) * 64 + lane] + red[(3 * 5 + j) * 64 + lane];
          mod[(size_t)(l * 5 + j) * 6144 + col] = s + P.b_ada[l * 6144 + col];
        }
      }
      __syncthreads();
    } else {
      float2* ta = (float2*)(P.ws + OFF_ROPEA); float2* tb = (float2*)(P.ws + OFF_ROPEB);
      for (int e = tid; e < 64 * 16 + 64 * 8; e += 256) {
        int pos, i, half;
        if (e < 1024) { pos = e >> 4; i = e & 15; half = 16; } else { int e2 = e - 1024; pos = e2 >> 3; i = e2 & 7; half = 8; }
        const double r16 = 0.5623413251903491;
        double inv = 1.0; int n = (half == 16) ? i : 2 * i;
        for (int q = 0; q < n; ++q) inv *= r16;
        float angf = (float)pos * (float)inv;
        double ang = (double)angf;
        double nq = rint(ang * 0.6366197723675814);
        double rr = ang - nq * 1.5707963267948966;
        double r2 = rr * rr;
        double sn = rr * (1.0 - r2 / 6.0 * (1.0 - r2 / 20.0 * (1.0 - r2 / 42.0 * (1.0 - r2 / 72.0 * (1.0 - r2 / 110.0 * (1.0 - r2 / 156.0))))));
        double cs = 1.0 - r2 / 2.0 * (1.0 - r2 / 12.0 * (1.0 - r2 / 30.0 * (1.0 - r2 / 56.0 * (1.0 - r2 / 90.0 * (1.0 - r2 / 132.0 * (1.0 - r2 / 182.0))))));
        int qd = ((int)nq) & 3;
        double c_, s_;
        if (qd == 0) { c_ = cs; s_ = sn; } else if (qd == 1) { c_ = -sn; s_ = cs; } else if (qd == 2) { c_ = -cs; s_ = -sn; } else { c_ = sn; s_ = -cs; }
        float2 v = make_float2((float)c_, (float)s_);
        if (e < 1024) ta[e] = v; else tb[e - 1024] = v;
      }
    }
  }
  {
    u16* d1 = (u16*)(P.ws + OFF_CWK);
    for (size_t e = (size_t)blockIdx.x * 256 + tid; e < (size_t)2 * 4 * 2 * 512 * 64; e += (size_t)gridDim.x * 256) {
      size_t inner = e & (size_t)(2 * 512 * 64 - 1); size_t lb = e / (2 * 512 * 64); int l = (int)(lb >> 2), b = (int)(lb & 3);
      d1[e] = f2bf(P.cwk[((size_t)(b * 2 + l)) * (2 * 512 * 64) + inner]);
    }
    u16* d2 = (u16*)(P.ws + OFF_CDK);
    for (size_t e = (size_t)blockIdx.x * 256 + tid; e < (size_t)2 * 4 * 4 * 2 * 512 * 32; e += (size_t)gridDim.x * 256) {
      size_t inner = e & (size_t)(4 * 2 * 512 * 32 - 1); size_t lb = e / (4 * 2 * 512 * 32); int l = (int)(lb >> 2), b = (int)(lb & 3);
      d2[e] = f2bf(P.cdk[((size_t)(b * 2 + l)) * (4 * 2 * 512 * 32) + inner]);
    }
  }
}

DI void norm_phase(const Params& P, int l, int g, int which) {
  const int tid_ = get_tid(); const int lane = tid_ & 63, w = tid_ >> 6;
  const float* mod = (const float*)(P.ws + OFF_MOD);
  u16* HB = (u16*)(P.ws + OFF_HB);
  const float* gn = (which ? P.norm2_g : P.norm1_g) + l * 1024;
  for (int row = blockIdx.x * 4 + w; row < GT; row += gridDim.x * 4) {
    int gtok = g * GT + row;
    const float* src;
    if (which == 0 && l == 0) src = gtok < NPT ? P.x_prompt + (size_t)gtok * 1024 : P.x_sample + (size_t)(gtok - NPT) * 1024;
    else src = P.out + (size_t)gtok * 1024;
    float4 v[4];
    float ss = 0.f;
#pragma unroll
    for (int i = 0; i < 4; ++i) { v[i] = *(const float4*)(src + (i * 64 + lane) * 4); ss += v[i].x * v[i].x + v[i].y * v[i].y + v[i].z * v[i].z + v[i].w * v[i].w; }
#pragma unroll
    for (int o = 32; o >= 1; o >>= 1) ss += __shfl_xor(ss, o);
    float rstd = rsqrtf(ss * (1.f / 1024.f) + EPS);
    const float* mrow = mod + (size_t)(l * 5 + cond_of(gtok)) * 6144;
    const float* sh = mrow + (which ? 3 : 0) * 1024; const float* sc = mrow + (which ? 4 : 1) * 1024;
#pragma unroll
    for (int i = 0; i < 4; ++i) {
      int col = (i * 64 + lane) * 4;
      float4 gg = *(const float4*)(gn + col), s4 = *(const float4*)(sc + col), h4 = *(const float4*)(sh + col);
      float a = v[i].x * rstd * gg.x * (1.f + s4.x) + h4.x, b = v[i].y * rstd * gg.y * (1.f + s4.y) + h4.y;
      float c = v[i].z * rstd * gg.z * (1.f + s4.z) + h4.z, d = v[i].w * rstd * gg.w * (1.f + s4.w) + h4.w;
      uint2 o2; o2.x = pack2(a, b); o2.y = pack2(c, d);
      *(uint2*)(HB + (size_t)row * 1024 + col) = o2;
    }
  }
}

enum { EPI_IN = 0, EPI_OUT = 1, EPI_FFN_IN = 2, EPI_FFN_OUT = 3 };

DI void store32_bf16(u16* dst, const float* v) {
#pragma unroll
  for (int i = 0; i < 4; ++i) { uint4 o; o.x = pack2(v[8 * i], v[8 * i + 1]); o.y = pack2(v[8 * i + 2], v[8 * i + 3]); o.z = pack2(v[8 * i + 4], v[8 * i + 5]); o.w = pack2(v[8 * i + 6], v[8 * i + 7]); *(uint4*)(dst + 8 * i) = o; }
}
DI void store32_f32(float* dst, const float* v) {
#pragma unroll
  for (int i = 0; i < 8; ++i) *(float4*)(dst + 4 * i) = make_float4(v[4 * i], v[4 * i + 1], v[4 * i + 2], v[4 * i + 3]);
}
DI void rope_axis16(float* v, const float2* tab, int pos) {
#pragma unroll
  for (int i = 0; i < 16; ++i) { float2 cs = tab[pos * 16 + i]; float a = v[i], b = v[i + 16]; v[i] = a * cs.x - b * cs.y; v[i + 16] = b * cs.x + a * cs.y; }
}
DI void rope_32(float* v, const float2* tab, int row, int col) {
#pragma unroll
  for (int i = 0; i < 8; ++i) { float2 cs = tab[row * 8 + i]; float a = v[i], b = v[i + 8]; v[i] = a * cs.x - b * cs.y; v[i + 8] = b * cs.x + a * cs.y; }
#pragma unroll
  for (int i = 0; i < 8; ++i) { float2 cs = tab[col * 8 + i]; float a = v[16 + i], b = v[24 + i]; v[16 + i] = a * cs.x - b * cs.y; v[24 + i] = b * cs.x + a * cs.y; }
}

DI void epi_in_segment(const Params& P, int l, int g, int ltok, int cb, float* v) {
  const int gtok = g * GT + ltok;
  const bool samp = gtok >= NPT;
  const int ts = (gtok - NPT) & 4095;
  const int pb = gtok >> 8, pt = gtok & 255;
  u16* Pb = (u16*)(P.ws + OFF_PB) + (size_t)ltok * PW;
  u16* VT = (u16*)(P.ws + OFF_VT);
  const float2* ta = (const float2*)(P.ws + OFF_ROPEA); const float2* tb = (const float2*)(P.ws + OFF_ROPEB);
  const int lane_par = (cb >> 5) & 1;
  if (cb < 256) {
    if (samp) rope_axis16(v, ta, lane_par ? (ts & 63) : (ts >> 6));
    store32_bf16(Pb + PC_RQ + cb, v);
  } else if (cb < 512) {
#pragma unroll
    for (int i = 0; i < 32; ++i) v[i] *= 0.125f;
    if (samp) rope_axis16(v, ta, lane_par ? (ts & 63) : (ts >> 6));
    store32_bf16(Pb + PC_RK + (cb - 256), v);
  } else if (cb < 768) {
    int c = cb - 512;
#pragma unroll
    for (int i = 0; i < 32; ++i) VT[(size_t)(VH_RET * 64 + c + i) * GT + ltok] = f2bf(v[i]);
  } else if (cb < 1024) {
#pragma unroll
    for (int i = 0; i < 32; ++i) v[i] = silu(v[i]);
    store32_bf16(Pb + PC_RG + (cb - 768), v);
  } else if (cb < 1408) {
    const bool isq = cb < 1280;
    float ss = 0.f;
#pragma unroll
    for (int i = 0; i < 32; ++i) ss += v[i] * v[i];
    ss += __shfl_xor(ss, 1);
    float rstd = rsqrtf(ss * (1.f / 64.f) + EPS);
    const float* gn = (isq ? P.win_q_norm : P.win_k_norm) + l * 64 + lane_par * 32;
#pragma unroll
    for (int i = 0; i < 32; ++i) v[i] = v[i] * rstd * gn[i];
    if (isq) {
      if (samp) rope_axis16(v, ta, lane_par ? (ts & 63) : (ts >> 6));
      store32_bf16(Pb + PC_WQ + (cb - 1024), v);
    } else {
      int c = cb - 1280; int kvh = c >> 6;
      if (!samp) store32_f32(P.out + O_CWK + ((size_t)((pb * 2 + l) * 2 + kvh) * 256 + pt) * 64 + (c & 63), v);
      else rope_axis16(v, ta, lane_par ? (ts & 63) : (ts >> 6));
      store32_bf16(Pb + PC_WK + c, v);
    }
  } else if (cb < 1536) {
    int c = cb - 1408; int kvh = c >> 6;
    if (!samp) store32_f32(P.out + O_CWV + ((size_t)((pb * 2 + l) * 2 + kvh) * 256 + pt) * 64 + (c & 63), v);
#pragma unroll
    for (int i = 0; i < 32; ++i) VT[(size_t)(VH_WIN * 64 + c + i) * GT + ltok] = f2bf(v[i]);
  } else if (cb < 2048) {
    const bool isq = cb < 1792;
    float ss = 0.f;
#pragma unroll
    for (int i = 0; i < 32; ++i) ss += v[i] * v[i];
    float rstd = rsqrtf(ss * (1.f / 32.f) + EPS);
    const float* gn = (isq ? P.diff_q_norm : P.diff_k_norm) + l * 32;
#pragma unroll
    for (int i = 0; i < 32; ++i) v[i] = v[i] * rstd * gn[i];
    if (isq) {
      if (samp) rope_32(v, tb, ts >> 6, ts & 63);
      store32_bf16(Pb + PC_DQ + (cb - 1536), v);
    } else {
      int c = cb - 1792; int h = c >> 6, comp = (c >> 5) & 1;
      if (!samp) store32_f32(P.out + O_CDK + ((size_t)(((pb * 2 + l) * 4 + h) * 2 + comp) * 256 + pt) * 32, v);
      else rope_32(v, tb, ts >> 6, ts & 63);
      store32_bf16(Pb + PC_DK + c, v);
    }
  } else if (cb < 2304) {
    int c = cb - 2048; int h = c >> 6;
    if (!samp) store32_f32(P.out + O_CDV + ((size_t)((pb * 2 + l) * 4 + h) * 256 + pt) * 64 + (c & 63), v);
#pragma unroll
    for (int i = 0; i < 32; ++i) VT[(size_t)(VH_DIFF * 64 + c + i) * GT + ltok] = f2bf(v[i]);
  } else if (cb < 2560) {
    store32_bf16(Pb + PC_HQ + (cb - 2304), v);
  } else if (cb < 3072) {
    const int dir = cb >= 2816 ? 1 : 0; const int c = cb - (dir ? 2816 : 2560);
    float* LF = (float*)(P.ws + OFF_LF) + ((size_t)dir * GT + ltok) * 256 + c;
#pragma unroll
    for (int i = 0; i < 32; ++i) {
      float lb = 0.f;
      if (l == 1) { float a0 = P.hgrn_lb[(0 * 2 + dir) * 256 + c + i], a1 = P.hgrn_lb[(1 * 2 + dir) * 256 + c + i]; lb = 1.f / (1.f + __expf(a1 - a0)); }
      float sg = 1.f / (1.f + __expf(-v[i]));
      float f = lb + (1.f - lb) * sg;
      v[i] = __logf(fmaxf(f, 1e-30f));
    }
    store32_f32(LF, v);
  } else if (cb < 3328) {
    int c = cb - 3072;
#pragma unroll
    for (int i = 0; i < 32; ++i) VT[(size_t)(VH_HGRN * 64 + c + i) * GT + ltok] = f2bf(v[i]);
  } else {
#pragma unroll
    for (int i = 0; i < 32; ++i) v[i] = silu(v[i]);
    store32_bf16(Pb + PC_HG + (cb - 3328), v);
  }
}

template <int EPI>
DI void gemm_phase(const Params& P, int l, int g, char* smem) {
  const u16* A; const u16* B; int lda, ldb, K, N;
  if (EPI == EPI_IN) { A = (const u16*)(P.ws + OFF_HB); lda = 1024; B = (const u16*)(P.ws + OFF_WIN) + (size_t)l * 3584 * 1024; ldb = 1024; K = 1024; N = 3584; }
  else if (EPI == EPI_OUT) { A = (const u16*)(P.ws + OFF_HB); lda = 1024; B = (const u16*)(P.ws + OFF_WOUT) + (size_t)l * 1024 * 1024; ldb = 1024; K = 1024; N = 1024; }
  else if (EPI == EPI_FFN_IN) { A = (const u16*)(P.ws + OFF_HB); lda = 1024; B = (const u16*)(P.ws + OFF_WFI) + (size_t)l * 5632 * 1024; ldb = 1024; K = 1024; N = 5632; }
  else { A = (const u16*)(P.ws + OFF_PB); lda = 2816; B = (const u16*)(P.ws + OFF_WFO) + (size_t)l * 1024 * 2816; ldb = 2816; K = 2816; N = 1024; }
  const int ntn = N / 128, ntm = GT / 128, nk = K / 64;
  const int tid = get_tid(), lane = tid & 63, w = tid >> 6, wm = w >> 1, wn = w & 1, fr = lane & 15, fq = lane >> 4;
  const int wr_off = (tid >> 3) * 128 + (((tid & 7) ^ ((tid >> 3) & 7)) * 16);
  const float* mod = (const float*)(P.ws + OFF_MOD);
  for (int idx = blockIdx.x; idx < ntm * ntn; idx += gridDim.x) {
    const int m0 = (idx / ntn) * 128, n0 = (idx % ntn) * 128;
    f32x4 acc[4][4];
#pragma unroll
    for (int i = 0; i < 4; ++i)
#pragma unroll
      for (int j = 0; j < 4; ++j) acc[i][j] = (f32x4){0.f, 0.f, 0.f, 0.f};
    const u16* Ap = A + (size_t)(m0 + (tid >> 3)) * lda + (tid & 7) * 8;
    const u16* Bp = B + (size_t)(n0 + (tid >> 3)) * ldb + (tid & 7) * 8;
    uint4 ra[4], rb[4];
#pragma unroll
    for (int i = 0; i < 4; ++i) { ra[i] = *(const uint4*)(Ap + (size_t)(32 * i) * lda); rb[i] = *(const uint4*)(Bp + (size_t)(32 * i) * ldb); }
#pragma unroll
    for (int i = 0; i < 4; ++i) { *(uint4*)(smem + wr_off + i * 4096) = ra[i]; *(uint4*)(smem + 32768 + wr_off + i * 4096) = rb[i]; }
    __syncthreads();
    for (int kt = 0; kt < nk; ++kt) {
      const int cur = kt & 1;
      if (kt + 1 < nk) {
#pragma unroll
        for (int i = 0; i < 4; ++i) { ra[i] = *(const uint4*)(Ap + (size_t)(32 * i) * lda + (kt + 1) * 64); rb[i] = *(const uint4*)(Bp + (size_t)(32 * i) * ldb + (kt + 1) * 64); }
      }
      const char* sa = smem + cur * 16384; const char* sb = smem + 32768 + cur * 16384;
#pragma unroll
      for (int ks = 0; ks < 2; ++ks) {
        bf16x8 af[4], bfr[4];
        const int sw = ((ks * 4 + fq) ^ (fr & 7)) * 16;
#pragma unroll
        for (int i = 0; i < 4; ++i) { af[i] = *(const bf16x8*)(sa + (wm * 64 + i * 16 + fr) * 128 + sw); bfr[i] = *(const bf16x8*)(sb + (wn * 64 + i * 16 + fr) * 128 + sw); }
#pragma unroll
        for (int i = 0; i < 4; ++i)
#pragma unroll
          for (int j = 0; j < 4; ++j) acc[i][j] = MFMA(af[i], bfr[j], acc[i][j]);
      }
      if (kt + 1 < nk) {
        const int nx = cur ^ 1;
#pragma unroll
        for (int i = 0; i < 4; ++i) { *(uint4*)(smem + nx * 16384 + wr_off + i * 4096) = ra[i]; *(uint4*)(smem + 32768 + nx * 16384 + wr_off + i * 4096) = rb[i]; }
      }
      __syncthreads();
    }
    const int gtok0 = g * GT + m0;
    const int cond = cond_of(gtok0);
    if (EPI == EPI_OUT || EPI == EPI_FFN_OUT) {
      const float* gate = mod + (size_t)(l * 5 + cond) * 6144 + (EPI == EPI_OUT ? 2 : 5) * 1024;
#pragma unroll
      for (int i = 0; i < 4; ++i)
#pragma unroll
        for (int r = 0; r < 4; ++r) {
          const int gtok = gtok0 + wm * 64 + i * 16 + fq * 4 + r;
          const float* xin;
          if (EPI == EPI_OUT && l == 0) xin = gtok < NPT ? P.x_prompt + (size_t)gtok * 1024 : P.x_sample + (size_t)(gtok - NPT) * 1024;
          else xin = P.out + (size_t)gtok * 1024;
          float* xo = P.out + (size_t)gtok * 1024;
#pragma unroll
          for (int j = 0; j < 4; ++j) { const int col = n0 + wn * 64 + j * 16 + fr; xo[col] = xin[col] + gate[col] * acc[i][j][r]; }
        }
    } else if (EPI == EPI_FFN_IN) {
      u16* ACT = (u16*)(P.ws + OFF_PB);
#pragma unroll
      for (int i = 0; i < 4; ++i)
#pragma unroll
        for (int r = 0; r < 4; ++r) {
          const int ltok = m0 + wm * 64 + i * 16 + fq * 4 + r;
#pragma unroll
          for (int jp = 0; jp < 2; ++jp) {
            const int q = (n0 + wn * 64) / 32 + jp;
            float gv = acc[i][2 * jp][r], uv = acc[i][2 * jp + 1][r];
            ACT[(size_t)ltok * 2816 + q * 16 + fr] = f2bf(silu(gv) * uv);
          }
        }
    } else {
      float* st = (float*)smem;
#pragma unroll
      for (int pass = 0; pass < 2; ++pass) {
        if (wm == pass) {
#pragma unroll
          for (int i = 0; i < 4; ++i)
#pragma unroll
            for (int j = 0; j < 4; ++j)
#pragma unroll
              for (int r = 0; r < 4; ++r) {
                const int rl = i * 16 + fq * 4 + r, cl = wn * 64 + j * 16 + fr;
                st[rl * 144 + (cl >> 5) * 36 + (cl & 31)] = acc[i][j][r];
              }
        }
        __syncthreads();
        {
          const int row = tid >> 2, seg = tid & 3;
          float v[32];
#pragma unroll
          for (int i = 0; i < 8; ++i) { float4 t = *(const float4*)(st + row * 144 + seg * 36 + 4 * i); v[4 * i] = t.x; v[4 * i + 1] = t.y; v[4 * i + 2] = t.z; v[4 * i + 3] = t.w; }
          epi_in_segment(P, l, g, m0 + pass * 64 + row, n0 + seg * 32, v);
        }
        __syncthreads();
      }
    }
  }
}

template <int MODE>
DI void attn_item(const Params& P, int l, int g, int item, char* smem) {
  const int tid = get_tid(), lane = tid & 63, w = tid >> 6, fr = lane & 15, fq = lane >> 4;
  const u16* Pb = (const u16*)(P.ws + OFF_PB);
  const u16* VT = (const u16*)(P.ws + OFF_VT);
  u16* MIX = (u16*)(P.ws + OFF_HB);
  int sc, h, qb;
  if (MODE == 0) { sc = item >> 7; int r = item & 127; h = r & 3; qb = r >> 2; } else { sc = item >> 8; int r = item & 255; h = r & 3; qb = r >> 2; }
  const int gsc = g * 3 + sc; const bool samp = gsc >= 2; const int b = gsc - 2;
  const int QB = (MODE == 0) ? 128 : 64;
  const int ltq0 = sc * 4096 + qb * QB;
  int t0, kstart_l, nloc, nctx, kstart_t;
  if (samp) {
    t0 = qb * QB;
    if (MODE == 0) { kstart_t = t0 - 128 < 0 ? 0 : t0 - 128; int kend = t0 + 256 > 4096 ? 4096 : t0 + 256; nloc = (kend - kstart_t) >> 6; }
    else { kstart_t = 0; nloc = 64; }
    nctx = 8; kstart_l = sc * 4096 + kstart_t;
  } else { t0 = ltq0 & 255; kstart_t = 0; kstart_l = ltq0 & ~255; nloc = 4; nctx = 0; }
  const int ntile = nloc + nctx;
  const int kvhead = (MODE == 0) ? (VH_WIN + (h >> 1)) : (VH_DIFF + h);
  const int kcol = (MODE == 0) ? (PC_WK + (h >> 1) * 64) : (PC_DK + h * 64);
  const u16* ctxK; const u16* ctxV;
  if (MODE == 0) { ctxK = (const u16*)(P.ws + OFF_CWK) + (size_t)((l * 4 + b) * 2 + (h >> 1)) * 512 * 64; ctxV = (const u16*)(P.ws + OFF_CWVT) + (size_t)((l * 4 + b) * 2 + (h >> 1)) * 64 * 512; }
  else { ctxK = (const u16*)(P.ws + OFF_CDK) + (size_t)((l * 4 + b) * 4 + h) * 2 * 512 * 32; ctxV = (const u16*)(P.ws + OFF_CDVT) + (size_t)((l * 4 + b) * 4 + h) * 64 * 512; }
  const int comp = (MODE == 1) ? (w & 1) : 0;
  const int qoff = (MODE == 0) ? 32 * w : 32 * (w >> 1);
  bf16x8 qf[2][2];
#pragma unroll
  for (int qt = 0; qt < 2; ++qt) {
    const u16* qp = Pb + (size_t)(ltq0 + qoff + qt * 16 + fr) * PW;
    if (MODE == 0) { qf[qt][0] = *(const bf16x8*)(qp + PC_WQ + h * 64 + fq * 8); qf[qt][1] = *(const bf16x8*)(qp + PC_WQ + h * 64 + 32 + fq * 8); }
    else { qf[qt][0] = *(const bf16x8*)(qp + PC_DQ + h * 64 + comp * 32 + fq * 8); qf[qt][1] = qf[qt][0]; }
  }
  const float scl = (MODE == 0 ? 0.125f : 0.17677669529663687f) * LOG2E;
  float mrun[2], lrun[2];
  if (MODE == 0) { float sk = P.win_sink[l * 4 + h] * LOG2E; mrun[0] = mrun[1] = sk; lrun[0] = lrun[1] = (fq == 0) ? 1.f : 0.f; }
  else { mrun[0] = mrun[1] = -1e30f; lrun[0] = lrun[1] = 0.f; }
  f32x4 o[4][2];
#pragma unroll
  for (int i = 0; i < 4; ++i) { o[i][0] = (f32x4){0.f, 0.f, 0.f, 0.f}; o[i][1] = (f32x4){0.f, 0.f, 0.f, 0.f}; }
  char* sK = smem; char* sV = smem + 16384; float* sX = (float*)(smem + 16384 + 18432);
  uint4 rk0, rk1, rv0, rv1;
#define ATT_LOAD1(RK, RV, I, J) { \
      const int c_ = tid + 256 * (I); const int row_ = c_ >> 3, ch_ = c_ & 7; \
      if ((J) < nloc) { \
        const int key0_ = kstart_l + (J) * 64; \
        RK = *(const uint4*)(Pb + (size_t)(key0_ + row_) * PW + kcol + ch_ * 8); \
        RV = *(const uint4*)(VT + (size_t)(kvhead * 64 + row_) * GT + key0_ + ch_ * 8); \
      } else { \
        const int jc_ = (J) - nloc; \
        if (MODE == 0) RK = *(const uint4*)(ctxK + (size_t)(jc_ * 64 + row_) * 64 + ch_ * 8); \
        else RK = *(const uint4*)(ctxK + (size_t)(ch_ >> 2) * 512 * 32 + (size_t)(jc_ * 64 + row_) * 32 + (ch_ & 3) * 8); \
        RV = *(const uint4*)(ctxV + (size_t)row_ * 512 + jc_ * 64 + ch_ * 8); \
      } }
#define ATT_WRITE1(RK, RV, I, BUF) { \
      const int c_ = tid + 256 * (I); const int row_ = c_ >> 3, ch_ = c_ & 7; \
      *(uint4*)(sK + (BUF) * 8192 + row_ * 128 + ((ch_ ^ (row_ & 7)) * 16)) = RK; \
      *(uint4*)(sV + (BUF) * 9216 + row_ * 144 + ch_ * 16) = RV; }
#define load_tile(J) { ATT_LOAD1(rk0, rv0, 0, J) ATT_LOAD1(rk1, rv1, 1, J) }
#define write_tile(BUF) { ATT_WRITE1(rk0, rv0, 0, BUF) ATT_WRITE1(rk1, rv1, 1, BUF) }
  __syncthreads();
  load_tile(0); write_tile(0);
  __syncthreads();
  for (int j = 0; j < ntile; ++j) {
    const int cur = j & 1;
    if (j + 1 < ntile) load_tile(j + 1);
    const char* kb = sK + cur * 8192; const char* vb = sV + cur * 9216;
    f32x4 s[4][2];
#pragma unroll
    for (int kt = 0; kt < 4; ++kt) {
      s[kt][0] = (f32x4){0.f, 0.f, 0.f, 0.f}; s[kt][1] = (f32x4){0.f, 0.f, 0.f, 0.f};
      if (MODE == 0) {
#pragma unroll
        for (int ks = 0; ks < 2; ++ks) {
          bf16x8 a = *(const bf16x8*)(kb + (kt * 16 + fr) * 128 + (((ks * 4 + fq) ^ (fr & 7)) * 16));
          s[kt][0] = MFMA(a, qf[0][ks], s[kt][0]); s[kt][1] = MFMA(a, qf[1][ks], s[kt][1]);
        }
      } else {
        bf16x8 a = *(const bf16x8*)(kb + (kt * 16 + fr) * 128 + (((comp * 4 + fq) ^ (fr & 7)) * 16));
        s[kt][0] = MFMA(a, qf[0][0], s[kt][0]); s[kt][1] = MFMA(a, qf[1][0], s[kt][1]);
      }
    }
    const bool domask = (MODE == 0) && samp && (j < nloc);
    bf16x8 pb[2][2];
#pragma unroll
    for (int qt = 0; qt < 2; ++qt) {
      float mx = -1e30f;
#pragma unroll
      for (int kt = 0; kt < 4; ++kt)
#pragma unroll
        for (int r = 0; r < 4; ++r) {
          float v = s[kt][qt][r] * scl;
          if (domask) { int tk = kstart_t + j * 64 + kt * 16 + fq * 4 + r; int tq = t0 + qoff + qt * 16 + fr; int d = tq - tk; if (d > 128 || d < -128) v = -1e30f; }
          s[kt][qt][r] = v; mx = fmaxf(mx, v);
        }
      mx = fmaxf(mx, __shfl_xor(mx, 16)); mx = fmaxf(mx, __shfl_xor(mx, 32));
      const float mnew = fmaxf(mrun[qt], mx);
      const float alpha = exp2f(mrun[qt] - mnew);
      mrun[qt] = mnew;
      float ls = 0.f;
#pragma unroll
      for (int kt = 0; kt < 4; ++kt)
#pragma unroll
        for (int r = 0; r < 4; ++r) { float p = exp2f(s[kt][qt][r] - mnew); s[kt][qt][r] = p; ls += p; }
      lrun[qt] = lrun[qt] * alpha + ls;
#pragma unroll
      for (int mt = 0; mt < 4; ++mt) o[mt][qt] *= alpha;
#pragma unroll
      for (int kk = 0; kk < 2; ++kk) {
        union { bf16x8 v; unsigned u[4]; } pk;
        pk.u[0] = pack2(s[2 * kk][qt][0], s[2 * kk][qt][1]); pk.u[1] = pack2(s[2 * kk][qt][2], s[2 * kk][qt][3]);
        pk.u[2] = pack2(s[2 * kk + 1][qt][0], s[2 * kk + 1][qt][1]); pk.u[3] = pack2(s[2 * kk + 1][qt][2], s[2 * kk + 1][qt][3]);
        pb[qt][kk] = pk.v;
      }
    }
#pragma unroll
    for (int kk = 0; kk < 2; ++kk)
#pragma unroll
      for (int mt = 0; mt < 4; ++mt) {
        s16x4 lo = *(const s16x4*)(vb + (mt * 16 + fr) * 144 + (kk * 32 + fq * 4) * 2);
        s16x4 hi = *(const s16x4*)(vb + (mt * 16 + fr) * 144 + (kk * 32 + 16 + fq * 4) * 2);
        bf16x8 a = __builtin_shufflevector(lo, hi, 0, 1, 2, 3, 4, 5, 6, 7);
        o[mt][0] = MFMA(a, pb[0][kk], o[mt][0]); o[mt][1] = MFMA(a, pb[1][kk], o[mt][1]);
      }
    if (j + 1 < ntile) write_tile(cur ^ 1);
    __syncthreads();
  }
#pragma unroll
  for (int qt = 0; qt < 2; ++qt) {
    float lt = lrun[qt]; lt += __shfl_xor(lt, 16); lt += __shfl_xor(lt, 32);
    const float inv = 1.f / lt;
#pragma unroll
    for (int mt = 0; mt < 4; ++mt) o[mt][qt] *= inv;
  }
  if (MODE == 0) {
#pragma unroll
    for (int qt = 0; qt < 2; ++qt) {
      u16* dst = MIX + (size_t)(ltq0 + qoff + qt * 16 + fr) * 1024 + 256 + h * 64;
#pragma unroll
      for (int mt = 0; mt < 4; ++mt) { uint2 v; v.x = pack2(o[mt][qt][0], o[mt][qt][1]); v.y = pack2(o[mt][qt][2], o[mt][qt][3]); *(uint2*)(dst + mt * 16 + fq * 4) = v; }
    }
  } else {
    float* xb = sX + (w >> 1) * (32 * 68);
    if (comp == 1) {
#pragma unroll
      for (int qt = 0; qt < 2; ++qt)
#pragma unroll
        for (int mt = 0; mt < 4; ++mt) *(float4*)(xb + (qt * 16 + fr) * 68 + mt * 16 + fq * 4) = make_float4(o[mt][qt][0], o[mt][qt][1], o[mt][qt][2], o[mt][qt][3]);
    }
    __syncthreads();
    if (comp == 0) {
      float d1 = 0.f, d2 = 0.f;
      const float* dl = P.diff_lambda + l * 128;
#pragma unroll
      for (int i = 0; i < 32; ++i) { d1 += dl[i] * dl[32 + i]; d2 += dl[64 + i] * dl[96 + i]; }
      const float lam_init = 0.8f - 0.6f * __expf(-0.3f * (float)l);
      const float lam = __expf(d1) - __expf(d2) + lam_init;
#pragma unroll
      for (int qt = 0; qt < 2; ++qt) {
        float ss = 0.f;
#pragma unroll
        for (int mt = 0; mt < 4; ++mt) {
          float4 o2 = *(const float4*)(xb + (qt * 16 + fr) * 68 + mt * 16 + fq * 4);
          o[mt][qt][0] -= lam * o2.x; o[mt][qt][1] -= lam * o2.y; o[mt][qt][2] -= lam * o2.z; o[mt][qt][3] -= lam * o2.w;
#pragma unroll
          for (int r = 0; r < 4; ++r) ss += o[mt][qt][r] * o[mt][qt][r];
        }
        ss += __shfl_xor(ss, 16); ss += __shfl_xor(ss, 32);
        const float rs = rsqrtf(ss * (1.f / 64.f) + EPS) * (1.f - lam_init);
        u16* dst = MIX + (size_t)(ltq0 + qoff + qt * 16 + fr) * 1024 + 512 + h * 64;
#pragma unroll
        for (int mt = 0; mt < 4; ++mt) {
          float4 gn = *(const float4*)(P.diff_norm_g + l * 256 + h * 64 + mt * 16 + fq * 4);
          uint2 v; v.x = pack2(o[mt][qt][0] * rs * gn.x, o[mt][qt][1] * rs * gn.y); v.y = pack2(o[mt][qt][2] * rs * gn.z, o[mt][qt][3] * rs * gn.w);
          *(uint2*)(dst + mt * 16 + fq * 4) = v;
        }
      }
    }
  }
}

#undef load_tile
#undef write_tile
DI void gla_state_item(const Params& P, int l, int g, int stream, int chunk, int h, char* smem) {
  const int tid = get_tid(), lane = tid & 63, w = tid >> 6, fr = lane & 15, fq = lane >> 4;
  const u16* Pb = (const u16*)(P.ws + OFF_PB);
  const u16* VT = (const u16*)(P.ws + OFF_VT);
  const float* LF = (const float*)(P.ws + OFF_LF);
  u16* sV = (u16*)smem; float* sCf = (float*)(smem + 9216); float* sCb = (float*)(smem + 26624); u16* sKf = (u16*)(smem + 44032); u16* sKb = (u16*)(smem + 53248);
  const int ltok0 = chunk * 64;
  const int vh = (stream == 0 ? VH_RET : VH_HGRN) + h;
  __syncthreads();
#pragma unroll
  for (int i = 0; i < 2; ++i) { const int c = tid + 256 * i; const int dv = c >> 3, ch = c & 7; *(uint4*)((char*)sV + dv * 144 + ch * 16) = *(const uint4*)(VT + (size_t)(vh * 64 + dv) * GT + ltok0 + ch * 8); }
  if (stream == 0) {
    const float lgf = -__expf(P.ret_decay[(l * 2 + 0) * 4 + h]), lgb = -__expf(P.ret_decay[(l * 2 + 1) * 4 + h]);
#pragma unroll
    for (int i = 0; i < 16; ++i) { const int e = tid + 256 * i; const int s = e >> 6, d = e & 63; sCf[s * 68 + d] = (float)(s + 1) * lgf; sCb[s * 68 + d] = (float)(s + 1) * lgb; }
    __syncthreads();
  } else {
#pragma unroll
    for (int i = 0; i < 4; ++i) {
      const int c = tid + 256 * i; const int s = c >> 4, d4 = (c & 15) * 4;
      *(float4*)(sCf + s * 68 + d4) = *(const float4*)(LF + ((size_t)0 * GT + ltok0 + s) * 256 + h * 64 + d4);
      *(float4*)(sCb + s * 68 + d4) = *(const float4*)(LF + ((size_t)1 * GT + ltok0 + s) * 256 + h * 64 + d4);
    }
    __syncthreads();
    const int d = tid & 63, part = tid >> 6;
    float af = 0.f, ab = 0.f;
#pragma unroll
    for (int i = 0; i < 16; ++i) { const int s = part * 16 + i; af += sCf[s * 68 + d]; sCf[s * 68 + d] = af; ab += sCb[s * 68 + d]; sCb[s * 68 + d] = ab; }
    __syncthreads();
    float of = 0.f, ob = 0.f;
    for (int p = 0; p < part; ++p) { of += sCf[(p * 16 + 15) * 68 + d]; ob += sCb[(p * 16 + 15) * 68 + d]; }
    __syncthreads();
#pragma unroll
    for (int i = 0; i < 16; ++i) { const int s = part * 16 + i; sCf[s * 68 + d] += of; sCb[s * 68 + d] += ob; }
    __syncthreads();
  }
  {
    const int s = tid & 63, db = (tid >> 6) * 16;
    const u16* kp = Pb + (size_t)(ltok0 + s) * PW + PC_RK + h * 64 + db;
#pragma unroll
    for (int i = 0; i < 16; ++i) {
      const int d = db + i;
      const float cf = sCf[s * 68 + d], cfp = s > 0 ? sCf[(s - 1) * 68 + d] : 0.f, lastf = sCf[63 * 68 + d];
      const float cbv = sCb[s * 68 + d], cbp = s > 0 ? sCb[(s - 1) * 68 + d] : 0.f;
      float kf, kb;
      if (stream == 0) { kf = bf2f(kp[i]); kb = kf; } else { kf = 1.f - __expf(cf - cfp); kb = 1.f - __expf(cbv - cbp); }
      sKf[d * 72 + s] = f2bf(kf * __expf(lastf - cf));
      sKb[d * 72 + s] = f2bf(kb * __expf(cbp));
    }
  }
  __syncthreads();
  float* ST = (float*)(P.ws + OFF_ST); float* DEC = (float*)(P.ws + OFF_DEC);
#pragma unroll
  for (int dir = 0; dir < 2; ++dir) {
    const u16* sK = dir ? sKb : sKf;
    float* dst = ST + ((size_t)((stream * NCH + chunk) * 2 + dir) * 4 + h) * 4096;
#pragma unroll
    for (int nt = 0; nt < 4; ++nt) {
      f32x4 acc = (f32x4){0.f, 0.f, 0.f, 0.f};
#pragma unroll
      for (int ks = 0; ks < 2; ++ks) {
        bf16x8 a = *(const bf16x8*)((const char*)sV + (16 * w + fr) * 144 + (ks * 4 + fq) * 16);
        bf16x8 bb = *(const bf16x8*)((const char*)sK + (nt * 16 + fr) * 144 + (ks * 4 + fq) * 16);
        acc = MFMA(a, bb, acc);
      }
#pragma unroll
      for (int r = 0; r < 4; ++r) dst[(16 * w + fq * 4 + r) * 64 + nt * 16 + fr] = acc[r];
    }
  }
  if (tid < 128) {
    const int dir = tid >> 6, d = tid & 63;
    DEC[((size_t)((stream * NCH + chunk) * 2 + dir) * 4 + h) * 64 + d] = __expf((dir ? sCb : sCf)[63 * 68 + d]);
  }
}

DI void scan_phase(const Params& P, int l, int g) {
  const int tid = get_tid();
  const int nseq = (g == 0) ? 33 : 3;
  float* ST = (float*)(P.ws + OFF_ST); const float* DEC = (const float*)(P.ws + OFF_DEC);
  for (int it = blockIdx.x; it < nseq * 256; it += gridDim.x) {
    const int sl = it >> 8, r = it & 255;
    const int stream = r >> 7, dir = (r >> 6) & 1, h = (r >> 4) & 3, slice = r & 15;
    const int e = slice * 256 + tid; const int dv = e >> 6, dk = e & 63;
    int chunk0, nch, b; bool samp;
    if (g == 0) { if (sl < 32) { samp = false; b = sl; chunk0 = sl * 4; nch = 4; } else { samp = true; b = 0; chunk0 = 128; nch = 64; } }
    else { samp = true; b = 1 + sl; chunk0 = sl * 64; nch = 64; }
    float s = 0.f;
    if (samp) { const float* s0 = (stream == 0 ? P.state_ret : P.state_hgrn); s = s0[((size_t)((b * 2 + l) * 2 + dir) * 4 + h) * 4096 + dk * 64 + dv]; }
    for (int c0 = 0; c0 < nch; c0 += 4) {
      float u[4], d[4]; size_t idx[4];
#pragma unroll
      for (int q = 0; q < 4; ++q) {
        const int ci = c0 + q; const int c = dir == 0 ? chunk0 + ci : chunk0 + nch - 1 - ci;
        const size_t base = (size_t)((stream * NCH + c) * 2 + dir) * 4 + h;
        idx[q] = base * 4096 + e; u[q] = ST[idx[q]]; d[q] = DEC[base * 64 + dk];
      }
#pragma unroll
      for (int q = 0; q < 4; ++q) { ST[idx[q]] = s; s = d[q] * s + u[q]; }
    }
    if (!samp) { float* so = P.out + (stream == 0 ? O_SRET : O_SHG); so[((size_t)((b * 2 + l) * 2 + dir) * 4 + h) * 4096 + dk * 64 + dv] = s; }
  }
}

DI void gla_out_item(const Params& P, int l, int g, int stream, int chunk, int h, char* smem) {
  const int tid = get_tid(), lane = tid & 63, w = tid >> 6, fr = lane & 15, fq = lane >> 4;
  const u16* Pb = (const u16*)(P.ws + OFF_PB);
  const u16* VT = (const u16*)(P.ws + OFF_VT);
  const float* LF = (const float*)(P.ws + OFF_LF);
  const float* ST = (const float*)(P.ws + OFF_ST);
  u16* MIX = (u16*)(P.ws + OFF_HB);
  char* sQ = smem; char* sK = smem + 8192; float* sC = (float*)(smem + 16384); char* sV = smem + 33792; char* sS = smem + 43008;
  const int ltok0 = chunk * 64;
  const int qcol = (stream == 0 ? PC_RQ : PC_HQ) + h * 64, gcol = (stream == 0 ? PC_RG : PC_HG) + h * 64;
  const int vh = (stream == 0 ? VH_RET : VH_HGRN) + h;
  f32x4 of[4];
#pragma unroll
  for (int i = 0; i < 4; ++i) of[i] = (f32x4){0.f, 0.f, 0.f, 0.f};
#pragma unroll 1
  for (int pass = 0; pass < 2; ++pass) {
    __syncthreads();
#pragma unroll
    for (int i = 0; i < 2; ++i) {
      const int c = tid + 256 * i; const int row = c >> 3, ch = c & 7;
      const int tok = pass ? ltok0 + 63 - row : ltok0 + row;
      *(uint4*)(sQ + row * 128 + ((ch ^ (row & 7)) * 16)) = *(const uint4*)(Pb + (size_t)tok * PW + qcol + ch * 8);
      if (stream == 0) *(uint4*)(sK + row * 128 + ((ch ^ (row & 7)) * 16)) = *(const uint4*)(Pb + (size_t)tok * PW + PC_RK + h * 64 + ch * 8);
      uint4 vv = *(const uint4*)(VT + (size_t)(vh * 64 + row) * GT + ltok0 + ch * 8);
      if (pass) {
        uint4 t;
        t.x = (vv.w >> 16) | (vv.w << 16); t.y = (vv.z >> 16) | (vv.z << 16); t.z = (vv.y >> 16) | (vv.y << 16); t.w = (vv.x >> 16) | (vv.x << 16);
        *(uint4*)(sV + row * 144 + (7 - ch) * 16) = t;
      } else *(uint4*)(sV + row * 144 + ch * 16) = vv;
    }
    {
      const int dv = tid >> 2, part = tid & 3;
      const float* sp = ST + ((size_t)((stream * NCH + chunk) * 2 + pass) * 4 + h) * 4096 + dv * 64 + part * 16;
      float t[16];
#pragma unroll
      for (int i = 0; i < 4; ++i) { float4 f = *(const float4*)(sp + 4 * i); t[4 * i] = f.x; t[4 * i + 1] = f.y; t[4 * i + 2] = f.z; t[4 * i + 3] = f.w; }
#pragma unroll
      for (int hh = 0; hh < 2; ++hh) {
        uint4 o4; o4.x = pack2(t[8 * hh], t[8 * hh + 1]); o4.y = pack2(t[8 * hh + 2], t[8 * hh + 3]); o4.z = pack2(t[8 * hh + 4], t[8 * hh + 5]); o4.w = pack2(t[8 * hh + 6], t[8 * hh + 7]);
        const int ch = part * 2 + hh;
        *(uint4*)(sS + dv * 128 + ((ch ^ (dv & 7)) * 16)) = o4;
      }
    }
    if (stream == 0) {
      const float lg = -__expf(P.ret_decay[(l * 2 + pass) * 4 + h]);
#pragma unroll
      for (int i = 0; i < 16; ++i) { const int e = tid + 256 * i; const int s = e >> 6, d = e & 63; sC[s * 68 + d] = (float)(s + 1) * lg; }
      __syncthreads();
    } else {
#pragma unroll
      for (int i = 0; i < 4; ++i) {
        const int c = tid + 256 * i; const int row = c >> 4, d4 = (c & 15) * 4;
        const int tok = pass ? ltok0 + 63 - row : ltok0 + row;
        *(float4*)(sC + row * 68 + d4) = *(const float4*)(LF + ((size_t)pass * GT + tok) * 256 + h * 64 + d4);
      }
      __syncthreads();
      {
        const int row = tid >> 2, part = tid & 3;
        float t[16];
#pragma unroll
        for (int i = 0; i < 16; ++i) t[i] = 1.f - __expf(sC[row * 68 + part * 16 + i]);
#pragma unroll
        for (int hh = 0; hh < 2; ++hh) {
          uint4 o4; o4.x = pack2(t[8 * hh], t[8 * hh + 1]); o4.y = pack2(t[8 * hh + 2], t[8 * hh + 3]); o4.z = pack2(t[8 * hh + 4], t[8 * hh + 5]); o4.w = pack2(t[8 * hh + 6], t[8 * hh + 7]);
          const int ch = part * 2 + hh;
          *(uint4*)(sK + row * 128 + ((ch ^ (row & 7)) * 16)) = o4;
        }
      }
      __syncthreads();
      const int d = tid & 63, part = tid >> 6;
      float a = 0.f;
#pragma unroll
      for (int i = 0; i < 16; ++i) { const int s = part * 16 + i; a += sC[s * 68 + d]; sC[s * 68 + d] = a; }
      __syncthreads();
      float off = 0.f;
      for (int p = 0; p < part; ++p) off += sC[(p * 16 + 15) * 68 + d];
      __syncthreads();
#pragma unroll
      for (int i = 0; i < 16; ++i) { const int s = part * 16 + i; sC[s * 68 + d] += off; }
      __syncthreads();
    }
    const int j = pass ? 3 - w : w;
    const int rowq = 16 * j + fr;
    bf16x8 qB[2], qI[2];
    float cj[2][8];
#pragma unroll
    for (int ks = 0; ks < 2; ++ks) {
      const int d0 = ks * 32 + fq * 8;
      bf16x8 q8 = *(const bf16x8*)(sQ + rowq * 128 + (((ks * 4 + fq) ^ (rowq & 7)) * 16));
      float4 c0 = *(const float4*)(sC + rowq * 68 + d0), c1 = *(const float4*)(sC + rowq * 68 + d0 + 4);
      float cq[8] = {c0.x, c0.y, c0.z, c0.w, c1.x, c1.y, c1.z, c1.w};
      if (j > 0) {
        float4 j0 = *(const float4*)(sC + (16 * j - 1) * 68 + d0), j1 = *(const float4*)(sC + (16 * j - 1) * 68 + d0 + 4);
        cj[ks][0] = j0.x; cj[ks][1] = j0.y; cj[ks][2] = j0.z; cj[ks][3] = j0.w; cj[ks][4] = j1.x; cj[ks][5] = j1.y; cj[ks][6] = j1.z; cj[ks][7] = j1.w;
      } else {
#pragma unroll
        for (int e = 0; e < 8; ++e) cj[ks][e] = 0.f;
      }
      union { bf16x8 v; unsigned u[4]; } ub, ui;
#pragma unroll
      for (int e = 0; e < 4; ++e) {
        float q0 = bf2f((u16)q8[2 * e]), q1 = bf2f((u16)q8[2 * e + 1]);
        ub.u[e] = pack2(q0 * __expf(cq[2 * e] - cj[ks][2 * e]), q1 * __expf(cq[2 * e + 1] - cj[ks][2 * e + 1]));
        ui.u[e] = pack2(q0 * __expf(cq[2 * e]), q1 * __expf(cq[2 * e + 1]));
      }
      qB[ks] = ub.v; qI[ks] = ui.v;
    }
    f32x4 st[4];
#pragma unroll
    for (int i = 0; i < 4; ++i) {
      st[i] = (f32x4){0.f, 0.f, 0.f, 0.f};
      if (i <= j) {
        const int rowk = 16 * i + fr;
#pragma unroll
        for (int ks = 0; ks < 2; ++ks) {
          const int d0 = ks * 32 + fq * 8;
          bf16x8 k8 = *(const bf16x8*)(sK + rowk * 128 + (((ks * 4 + fq) ^ (rowk & 7)) * 16));
          float4 c0 = *(const float4*)(sC + rowk * 68 + d0), c1 = *(const float4*)(sC + rowk * 68 + d0 + 4);
          float ck[8] = {c0.x, c0.y, c0.z, c0.w, c1.x, c1.y, c1.z, c1.w};
          union { bf16x8 v; unsigned u[4]; } ua;
#pragma unroll
          for (int e = 0; e < 4; ++e) {
            float k0 = bf2f((u16)k8[2 * e]), k1 = bf2f((u16)k8[2 * e + 1]);
            ua.u[e] = pack2(k0 * __expf(fminf(cj[ks][2 * e] - ck[2 * e], 80.f)), k1 * __expf(fminf(cj[ks][2 * e + 1] - ck[2 * e + 1], 80.f)));
          }
          st[i] = MFMA(ua.v, qB[ks], st[i]);
        }
        if (i == j) {
#pragma unroll
          for (int r = 0; r < 4; ++r) if (fq * 4 + r > fr) st[i][r] = 0.f;
        }
      }
    }
    f32x4 o[4];
#pragma unroll
    for (int i = 0; i < 4; ++i) o[i] = (f32x4){0.f, 0.f, 0.f, 0.f};
#pragma unroll
    for (int kk = 0; kk < 2; ++kk) {
      if (2 * kk <= j) {
        union { bf16x8 v; unsigned u[4]; } pk;
        pk.u[0] = pack2(st[2 * kk][0], st[2 * kk][1]); pk.u[1] = pack2(st[2 * kk][2], st[2 * kk][3]);
        pk.u[2] = pack2(st[2 * kk + 1][0], st[2 * kk + 1][1]); pk.u[3] = pack2(st[2 * kk + 1][2], st[2 * kk + 1][3]);
#pragma unroll
        for (int mt = 0; mt < 4; ++mt) {
          s16x4 lo = *(const s16x4*)(sV + (mt * 16 + fr) * 144 + (kk * 32 + fq * 4) * 2);
          s16x4 hi = *(const s16x4*)(sV + (mt * 16 + fr) * 144 + (kk * 32 + 16 + fq * 4) * 2);
          bf16x8 a = __builtin_shufflevector(lo, hi, 0, 1, 2, 3, 4, 5, 6, 7);
          o[mt] = MFMA(a, pk.v, o[mt]);
        }
      }
    }
#pragma unroll
    for (int ks = 0; ks < 2; ++ks)
#pragma unroll
      for (int mt = 0; mt < 4; ++mt) {
        const int rs = mt * 16 + fr;
        bf16x8 a = *(const bf16x8*)(sS + rs * 128 + (((ks * 4 + fq) ^ (rs & 7)) * 16));
        o[mt] = MFMA(a, qI[ks], o[mt]);
      }
    if (pass == 0) {
#pragma unroll
      for (int mt = 0; mt < 4; ++mt) of[mt] = o[mt];
    } else {
      const int srcl = (lane & 48) | (15 - fr);
#pragma unroll
      for (int mt = 0; mt < 4; ++mt)
#pragma unroll
        for (int r = 0; r < 4; ++r) of[mt][r] += __shfl(o[mt][r], srcl);
    }
  }
  const int tok = ltok0 + 16 * w + fr;
  float ss = 0.f;
#pragma unroll
  for (int mt = 0; mt < 4; ++mt)
#pragma unroll
    for (int r = 0; r < 4; ++r) ss += of[mt][r] * of[mt][r];
  ss += __shfl_xor(ss, 16); ss += __shfl_xor(ss, 32);
  const float rs = rsqrtf(ss * (1.f / 64.f) + EPS);
  const float* gnp = (stream == 0 ? P.ret_norm_g : P.hgrn_norm_g) + l * 256 + h * 64;
  u16* dst = MIX + (size_t)tok * 1024 + (stream == 0 ? 0 : 768) + h * 64;
#pragma unroll
  for (int mt = 0; mt < 4; ++mt) {
    const int dv = mt * 16 + fq * 4;
    float4 gn = *(const float4*)(gnp + dv);
    uint2 gt = *(const uint2*)(Pb + (size_t)tok * PW + gcol + dv);
    float g0 = bf2f((u16)(gt.x & 0xffff)), g1 = bf2f((u16)(gt.x >> 16)), g2 = bf2f((u16)(gt.y & 0xffff)), g3 = bf2f((u16)(gt.y >> 16));
    uint2 v; v.x = pack2(of[mt][0] * rs * gn.x * g0, of[mt][1] * rs * gn.y * g1); v.y = pack2(of[mt][2] * rs * gn.z * g2, of[mt][3] * rs * gn.w * g3);
    *(uint2*)(dst + dv) = v;
  }
}

DI void mix1_phase(const Params& P, int l, int g, char* smem) {
  constexpr int N_DIFF = 768, N_WIN = 384, N_ST = 2 * NCH * 4;
  for (int it = blockIdx.x; it < N_DIFF + N_WIN + N_ST; it += gridDim.x) {
    if (it < N_DIFF) attn_item<1>(P, l, g, it, smem);
    else if (it < N_DIFF + N_WIN) attn_item<0>(P, l, g, it - N_DIFF, smem);
    else { int r = it - N_DIFF - N_WIN; int stream = r / (NCH * 4); int rr = r % (NCH * 4); gla_state_item(P, l, g, stream, rr >> 2, rr & 3, smem); }
  }
}
DI void mix3_phase(const Params& P, int l, int g, char* smem) {
  for (int it = blockIdx.x; it < 2 * NCH * 4; it += gridDim.x) { int stream = it / (NCH * 4); int rr = it % (NCH * 4); gla_out_item(P, l, g, stream, rr >> 2, rr & 3, smem); }
}

__global__ void __launch_bounds__(256, 2) hybrid_megakernel(Params P) {
  __shared__ __attribute__((aligned(16))) char smem[65536];
  cg::grid_group grid = cg::this_grid();
  prep_phase(P, smem);
  grid.sync();
  for (int l = 0; l < 2; ++l) {
    for (int g = 0; g < NGROUP; ++g) {
      norm_phase(P, l, g, 0);
      grid.sync();
      gemm_phase<EPI_IN>(P, l, g, smem);
      grid.sync();
      mix1_phase(P, l, g, smem);
      grid.sync();
      scan_phase(P, l, g);
      grid.sync();
      mix3_phase(P, l, g, smem);
      grid.sync();
      gemm_phase<EPI_OUT>(P, l, g, smem);
      grid.sync();
      norm_phase(P, l, g, 1);
      grid.sync();
      gemm_phase<EPI_FFN_IN>(P, l, g, smem);
      grid.sync();
      gemm_phase<EPI_FFN_OUT>(P, l, g, smem);
    }
  }
}

extern "C" void kernel_launch(void* const* d_in, const int* in_sizes, int n_in, void* d_out, int out_size, void* d_ws, size_t ws_size,
                              hipStream_t stream) {
  static int grid_blocks = 0;
  if (!grid_blocks) {
    int dev = 0, cus = 0, per_cu = 0;
    hipGetDevice(&dev);
    hipDeviceGetAttribute(&cus, hipDeviceAttributeMultiprocessorCount, dev);
    hipOccupancyMaxActiveBlocksPerMultiprocessor(&per_cu, hybrid_megakernel, 256, 0);
    if (per_cu > 2) per_cu = 2;
    if (per_cu < 1) per_cu = 1;
    grid_blocks = cus * per_cu;
  }
  if (ws_size < WS_TOTAL) fprintf(stderr, "workspace too small: %zu < %zu\n", ws_size, (size_t)WS_TOTAL);
  Params p{};
  const float** pp = (const float**)&p;
  for (int i = 0; i < 29; ++i) pp[i] = (const float*)d_in[i];
  p.out = (float*)d_out;
  p.ws = (char*)d_ws;
  void* args[] = {&p};
  hipError_t e = hipLaunchCooperativeKernel((void*)hybrid_megakernel, dim3(grid_blocks), dim3(256), args, 0, stream);
  if (e != hipSuccess) fprintf(stderr, "cooperative launch failed: %s (grid %d)\n", hipGetErrorString(e), grid_blocks);
}
```

```cpp
#include <hip/hip_runtime.h>
#include <hip/hip_cooperative_groups.h>
#include <cstdio>
namespace cg = cooperative_groups;

typedef unsigned short u16;
typedef __attribute__((ext_vector_type(8))) short bf16x8;
typedef __attribute__((ext_vector_type(4))) short s16x4;
typedef __attribute__((ext_vector_type(4))) float f32x4;
#define DI __device__ __forceinline__
#define MFMA(a, b, c) __builtin_amdgcn_mfma_f32_16x16x32_bf16((a), (b), (c), 0, 0, 0)

constexpr int NPT = 8192;
constexpr int GT = 12288;
constexpr int NGROUP = 2;
constexpr int PW = 2176;
constexpr int NCH = GT / 64;
constexpr float EPS = 1e-6f;
constexpr float LOG2E = 1.4426950408889634f;

constexpr int PC_RQ = 0, PC_RK = 256, PC_RG = 512, PC_WQ = 768, PC_WK = 1024, PC_DQ = 1152, PC_DK = 1408, PC_HQ = 1664, PC_HG = 1920;
constexpr int VH_RET = 0, VH_WIN = 4, VH_DIFF = 6, VH_HGRN = 10;

constexpr size_t OFF_MOD = 16384;
constexpr size_t OFF_ROPEA = OFF_MOD + 2 * 5 * 6144 * 4;
constexpr size_t OFF_ROPEB = OFF_ROPEA + 64 * 16 * 8;
constexpr size_t OFF_WIN = OFF_ROPEB + 64 * 8 * 8;
constexpr size_t OFF_WOUT = OFF_WIN + (size_t)2 * 3584 * 1024 * 2;
constexpr size_t OFF_WFI = OFF_WOUT + (size_t)2 * 1024 * 1024 * 2;
constexpr size_t OFF_WFO = OFF_WFI + (size_t)2 * 5632 * 1024 * 2;
constexpr size_t OFF_CWK = OFF_WFO + (size_t)2 * 1024 * 2816 * 2;
constexpr size_t OFF_CWVT = OFF_CWK + (size_t)2 * 4 * 2 * 512 * 64 * 2;
constexpr size_t OFF_CDK = OFF_CWVT + (size_t)2 * 4 * 2 * 512 * 64 * 2;
constexpr size_t OFF_CDVT = OFF_CDK + (size_t)2 * 4 * 4 * 2 * 512 * 32 * 2;
constexpr size_t OFF_HB = OFF_CDVT + (size_t)2 * 4 * 4 * 64 * 512 * 2;
constexpr size_t OFF_PB = OFF_HB + (size_t)GT * 1024 * 2;
constexpr size_t OFF_VT = OFF_PB + (size_t)GT * 2816 * 2;
constexpr size_t OFF_LF = OFF_VT + (size_t)14 * 64 * GT * 2;
constexpr size_t OFF_ST = OFF_LF + (size_t)2 * GT * 256 * 4;
constexpr size_t OFF_DEC = OFF_ST + (size_t)2 * NCH * 2 * 4 * 4096 * 4;
constexpr size_t WS_TOTAL = OFF_DEC + (size_t)2 * NCH * 2 * 4 * 64 * 4;

constexpr size_t O_SRET = 25165824, O_CWK = 27262976, O_CWV = 29360128, O_CDK = 31457280, O_CDV = 35651584, O_SHG = 39845888;

struct Params {
  const float *x_prompt, *x_sample, *state_ret, *cwk, *cwv, *cdk, *cdv, *state_hgrn, *c, *c_ctx, *norm1_g, *norm2_g, *w_ada, *b_ada,
      *w_in, *ret_decay, *ret_norm_g, *win_q_norm, *win_k_norm, *win_sink, *diff_q_norm, *diff_k_norm, *diff_lambda, *diff_norm_g,
      *hgrn_lb, *hgrn_norm_g, *w_out, *w_ffn_in, *w_ffn_out;
  float* out;
  char* ws;
};

DI u16 f2bf(float x) { unsigned u = __float_as_uint(x); u += 0x7fffu + ((u >> 16) & 1u); return (u16)(u >> 16); }
DI float bf2f(u16 h) { return __uint_as_float(((unsigned)h) << 16); }
DI unsigned pack2(float a, float b) { return (unsigned)f2bf(a) | ((unsigned)f2bf(b) << 16); }
DI float silu(float x) { return x / (1.f + __expf(-x)); }
DI int get_tid() { int t = threadIdx.x; asm volatile("" : "+v"(t)); return t; }
DI int cond_of(int gtok) { return gtok < NPT ? 0 : 1 + ((gtok - NPT) >> 12); }

template <class RM>
DI void transpose_tile(const float* __restrict__ src, size_t ld_src, u16* __restrict__ dst, size_t ld_dst, float* sm, RM rowmap) {
  const int tid = get_tid();
#pragma unroll
  for (int i = 0; i < 16; ++i) { int e = tid + 256 * i; int r = e >> 6, c = e & 63; sm[r * 65 + c] = src[(size_t)r * ld_src + c]; }
  __syncthreads();
#pragma unroll
  for (int i = 0; i < 16; ++i) { int e = tid + 256 * i; int c = e >> 6, r = e & 63; dst[(size_t)rowmap(c) * ld_dst + r] = f2bf(sm[r * 65 + c]); }
  __syncthreads();
}

DI void prep_phase(const Params& P, char* smem) {
  float* sm = (float*)smem;
  const int tid = get_tid();
  constexpr int PER_L = 896 + 256 + 1408 + 704;
  constexpr int N_W = 2 * PER_L;
  constexpr int N_CWV = 128, N_CDV = 256, N_MOD = 192;
  constexpr int TOTAL = N_W + N_CWV + N_CDV + N_MOD + 1;
  for (int it = blockIdx.x; it < TOTAL; it += gridDim.x) {
    if (it < N_W) {
      int l = it / PER_L, r = it % PER_L;
      if (r < 896) {
        int kt = r / 56, nt = r % 56;
        const float* src = P.w_in + (size_t)l * 1024 * 3584 + (size_t)kt * 64 * 3584 + nt * 64;
        u16* dst = (u16*)(P.ws + OFF_WIN) + (size_t)l * 3584 * 1024 + kt * 64;
        int nb = nt * 64;
        transpose_tile(src, 3584, dst, 1024, sm, [nb](int c) { return nb + c; });
      } else if (r < 1152) {
        r -= 896; int kt = r / 16, nt = r % 16;
        const float* src = P.w_out + (size_t)l * 1024 * 1024 + (size_t)kt * 64 * 1024 + nt * 64;
        u16* dst = (u16*)(P.ws + OFF_WOUT) + (size_t)l * 1024 * 1024 + kt * 64;
        int nb = nt * 64;
        transpose_tile(src, 1024, dst, 1024, sm, [nb](int c) { return nb + c; });
      } else if (r < 2560) {
        r -= 1152; int kt = r / 88, nt = r % 88;
        const float* src = P.w_ffn_in + (size_t)l * 1024 * 5632 + (size_t)kt * 64 * 5632 + nt * 64;
        u16* dst = (u16*)(P.ws + OFF_WFI) + (size_t)l * 5632 * 1024 + kt * 64;
        int nb = nt * 64;
        transpose_tile(src, 5632, dst, 1024, sm, [nb](int c) { int n = nb + c; int s = n >= 2816 ? 1 : 0; int jn = n - s * 2816; return 32 * (jn >> 4) + 16 * s + (jn & 15); });
      } else {
        r -= 2560; int kt = r / 16, nt = r % 16;
        const float* src = P.w_ffn_out + (size_t)l * 2816 * 1024 + (size_t)kt * 64 * 1024 + nt * 64;
        u16* dst = (u16*)(P.ws + OFF_WFO) + (size_t)l * 1024 * 2816 + kt * 64;
        int nb = nt * 64;
        transpose_tile(src, 1024, dst, 2816, sm, [nb](int c) { return nb + c; });
      }
    } else if (it < N_W + N_CWV) {
      int r = it - N_W; int mat = r >> 3, kt = r & 7;
      const float* src = P.cwv + (size_t)mat * 512 * 64 + (size_t)kt * 64 * 64;
      const int dm = (((mat >> 1) & 1) * 4 + (mat >> 2)) * 2 + (mat & 1);
      u16* dst = (u16*)(P.ws + OFF_CWVT) + (size_t)dm * 64 * 512 + kt * 64;
      transpose_tile(src, 64, dst, 512, sm, [](int c) { return c; });
    } else if (it < N_W + N_CWV + N_CDV) {
      int r = it - N_W - N_CWV; int mat = r >> 3, kt = r & 7;
      const float* src = P.cdv + (size_t)mat * 512 * 64 + (size_t)kt * 64 * 64;
      const int dm = (((mat >> 2) & 1) * 4 + (mat >> 3)) * 4 + (mat & 3);
      u16* dst = (u16*)(P.ws + OFF_CDVT) + (size_t)dm * 64 * 512 + kt * 64;
      transpose_tile(src, 64, dst, 512, sm, [](int c) { return c; });
    } else if (it < N_W + N_CWV + N_CDV + N_MOD) {
      int r = it - N_W - N_CWV - N_CDV; int l = r / 96, cb = r % 96;
      for (int e = tid; e < 5 * 1024; e += 256) { int j = e >> 10, k = e & 1023; float v = (j == 0) ? P.c_ctx[k] : P.c[(j - 1) * 1024 + k]; sm[e] = silu(v); }
      __syncthreads();
      const int w = tid >> 6, lane = tid & 63; const int col = cb * 64 + lane;
      float acc[5] = {0.f, 0.f, 0.f, 0.f, 0.f};
      const float* wp = P.w_ada + (size_t)l * 1024 * 6144 + col;
#pragma unroll 8
      for (int k = w * 256; k < w * 256 + 256; ++k) {
        float wv = wp[(size_t)k * 6144];
#pragma unroll
        for (int j = 0; j < 5; ++j) acc[j] += sm[j * 1024 + k] * wv;
      }
      float* red = sm + 5 * 1024;
#pragma unroll
      for (int j = 0; j < 5; ++j) red[(w * 5 + j) * 64 + lane] = acc[j];
      __syncthreads();
      if (w == 0) {
        float* mod = (float*)(P.ws + OFF_MOD);
#pragma unroll
        for (int j = 0; j < 5; ++j) {
          float s = red[(0 * 5 + j) * 64 + lane] + red[(1 * 5 + j) * 64 + lane] + red[(2 * 5 + j) * 64 + lane] + red[(3 * 5 + j) * 64 + lane];
          mod[(size_t)(l * 5 + j) * 6144 + col] = s + P.b_ada[l * 6144 + col];
        }
      }
      __syncthreads();
    } else {
      float2* ta = (float2*)(P.ws + OFF_ROPEA); float2* tb = (float2*)(P.ws + OFF_ROPEB);
      for (int e = tid; e < 64 * 16 + 64 * 8; e += 256) {
        int pos, i, half;
        if (e < 1024) { pos = e >> 4; i = e & 15; half = 16; } else { int e2 = e - 1024; pos = e2 >> 3; i = e2 & 7; half = 8; }
        const double r16 = 0.5623413251903491;
        double inv = 1.0; int n = (half == 16) ? i : 2 * i;
        for (int q = 0; q < n; ++q) inv *= r16;
        float angf = (float)pos * (float)inv;
        double ang = (double)angf;
        double nq = rint(ang * 0.6366197723675814);
        double rr = ang - nq * 1.5707963267948966;
        double r2 = rr * rr;
        double sn = rr * (1.0 - r2 / 6.0 * (1.0 - r2 / 20.0 * (1.0 - r2 / 42.0 * (1.0 - r2 / 72.0 * (1.0 - r2 / 110.0 * (1.0 - r2 / 156.0))))));
        double cs = 1.0 - r2 / 2.0 * (1.0 - r2 / 12.0 * (1.0 - r2 / 30.0 * (1.0 - r2 / 56.0 * (1.0 - r2 / 90.0 * (1.0 - r2 / 132.0 * (1.0 - r2 / 182.0))))));
        int qd = ((int)nq) & 3;
        double c_, s_;
        if (qd == 0) { c_ = cs; s_ = sn; } else if (qd == 1) { c_ = -sn; s_ = cs; } else if (qd == 2) { c_ = -cs; s_ = -sn; } else { c_ = sn; s_ = -cs; }
        float2 v = make_float2((float)c_, (float)s_);
        if (e < 1024) ta[e] = v; else tb[e - 1024] = v;
      }
    }
  }
  {
    u16* d1 = (u16*)(P.ws + OFF_CWK);
    for (size_t e = (size_t)blockIdx.x * 256 + tid; e < (size_t)2 * 4 * 2 * 512 * 64; e += (size_t)gridDim.x * 256) {
      size_t inner = e & (size_t)(2 * 512 * 64 - 1); size_t lb = e / (2 * 512 * 64); int l = (int)(lb >> 2), b = (int)(lb & 3);
      d1[e] = f2bf(P.cwk[((size_t)(b * 2 + l)) * (2 * 512 * 64) + inner]);
    }
    u16* d2 = (u16*)(P.ws + OFF_CDK);
    for (size_t e = (size_t)blockIdx.x * 256 + tid; e < (size_t)2 * 4 * 4 * 2 * 512 * 32; e += (size_t)gridDim.x * 256) {
      size_t inner = e & (size_t)(4 * 2 * 512 * 32 - 1); size_t lb = e / (4 * 2 * 512 * 32); int l = (int)(lb >> 2), b = (int)(lb & 3);
      d2[e] = f2bf(P.cdk[((size_t)(b * 2 + l)) * (4 * 2 * 512 * 32) + inner]);
    }
  }
}

DI void norm_phase(const Params& P, int l, int g, int which) {
  const int tid_ = get_tid(); const int lane = tid_ & 63, w = tid_ >> 6;
  const float* mod = (const float*)(P.ws + OFF_MOD);
  u16* HB = (u16*)(P.ws + OFF_HB);
  const float* gn = (which ? P.norm2_g : P.norm1_g) + l * 1024;
  for (int row = blockIdx.x * 4 + w; row < GT; row += gridDim.x * 4) {
    int gtok = g * GT + row;
    const float* src;
    if (which == 0 && l == 0) src = gtok < NPT ? P.x_prompt + (size_t)gtok * 1024 : P.x_sample + (size_t)(gtok - NPT) * 1024;
    else src = P.out + (size_t)gtok * 1024;
    float4 v[4];
    float ss = 0.f;
#pragma unroll
    for (int i = 0; i < 4; ++i) { v[i] = *(const float4*)(src + (i * 64 + lane) * 4); ss += v[i].x * v[i].x + v[i].y * v[i].y + v[i].z * v[i].z + v[i].w * v[i].w; }
#pragma unroll
    for (int o = 32; o >= 1; o >>= 1) ss += __shfl_xor(ss, o);
    float rstd = rsqrtf(ss * (1.f / 1024.f) + EPS);
    const float* mrow = mod + (size_t)(l * 5 + cond_of(gtok)) * 6144;
    const float* sh = mrow + (which ? 3 : 0) * 1024; const float* sc = mrow + (which ? 4 : 1) * 1024;
#pragma unroll
    for (int i = 0; i < 4; ++i) {
      int col = (i * 64 + lane) * 4;
      float4 gg = *(const float4*)(gn + col), s4 = *(const float4*)(sc + col), h4 = *(const float4*)(sh + col);
      float a = v[i].x * rstd * gg.x * (1.f + s4.x) + h4.x, b = v[i].y * rstd * gg.y * (1.f + s4.y) + h4.y;
      float c = v[i].z * rstd * gg.z * (1.f + s4.z) + h4.z, d = v[i].w * rstd * gg.w * (1.f + s4.w) + h4.w;
      uint2 o2; o2.x = pack2(a, b); o2.y = pack2(c, d);
      *(uint2*)(HB + (size_t)row * 1024 + col) = o2;
    }
  }
}

enum { EPI_IN = 0, EPI_OUT = 1, EPI_FFN_IN = 2, EPI_FFN_OUT = 3 };

DI void store32_bf16(u16* dst, const float* v) {
#pragma unroll
  for (int i = 0; i < 4; ++i) { uint4 o; o.x = pack2(v[8 * i], v[8 * i + 1]); o.y = pack2(v[8 * i + 2], v[8 * i + 3]); o.z = pack2(v[8 * i + 4], v[8 * i + 5]); o.w = pack2(v[8 * i + 6], v[8 * i + 7]); *(uint4*)(dst + 8 * i) = o; }
}
DI void store32_f32(float* dst, const float* v) {
#pragma unroll
  for (int i = 0; i < 8; ++i) *(float4*)(dst + 4 * i) = make_float4(v[4 * i], v[4 * i + 1], v[4 * i + 2], v[4 * i + 3]);
}
DI void rope_axis16(float* v, const float2* tab, int pos) {
#pragma unroll
  for (int i = 0; i < 16; ++i) { float2 cs = tab[pos * 16 + i]; float a = v[i], b = v[i + 16]; v[i] = a * cs.x - b * cs.y; v[i + 16] = b * cs.x + a * cs.y; }
}
DI void rope_32(float* v, const float2* tab, int row, int col) {
#pragma unroll
  for (int i = 0; i < 8; ++i) { float2 cs = tab[row * 8 + i]; float a = v[i], b = v[i + 8]; v[i] = a * cs.x - b * cs.y; v[i + 8] = b * cs.x + a * cs.y; }
#pragma unroll
  for (int i = 0; i < 8; ++i) { float2 cs = tab[col * 8 + i]; float a = v[16 + i], b = v[24 + i]; v[16 + i] = a * cs.x - b * cs.y; v[24 + i] = b * cs.x + a * cs.y; }
}

DI void epi_in_segment(const Params& P, int l, int g, int ltok, int cb, float* v) {
  const int gtok = g * GT + ltok;
  const bool samp = gtok >= NPT;
  const int ts = (gtok - NPT) & 4095;
  const int pb = gtok >> 8, pt = gtok & 255;
  u16* Pb = (u16*)(P.ws + OFF_PB) + (size_t)ltok * PW;
  u16* VT = (u16*)(P.ws + OFF_VT);
  const float2* ta = (const float2*)(P.ws + OFF_ROPEA); const float2* tb = (const float2*)(P.ws + OFF_ROPEB);
  const int lane_par = (cb >> 5) & 1;
  if (cb < 256) {
    if (samp) rope_axis16(v, ta, lane_par ? (ts & 63) : (ts >> 6));
    store32_bf16(Pb + PC_RQ + cb, v);
  } else if (cb < 512) {
#pragma unroll
    for (int i = 0; i < 32; ++i) v[i] *= 0.125f;
    if (samp) rope_axis16(v, ta, lane_par ? (ts & 63) : (ts >> 6));
    store32_bf16(Pb + PC_RK + (cb - 256), v);
  } else if (cb < 768) {
    int c = cb - 512;
#pragma unroll
    for (int i = 0; i < 32; ++i) VT[(size_t)(VH_RET * 64 + c + i) * GT + ltok] = f2bf(v[i]);
  } else if (cb < 1024) {
#pragma unroll
    for (int i = 0; i < 32; ++i) v[i] = silu(v[i]);
    store32_bf16(Pb + PC_RG + (cb - 768), v);
  } else if (cb < 1408) {
    const bool isq = cb < 1280;
    float ss = 0.f;
#pragma unroll
    for (int i = 0; i < 32; ++i) ss += v[i] * v[i];
    ss += __shfl_xor(ss, 1);
    float rstd = rsqrtf(ss * (1.f / 64.f) + EPS);
    const float* gn = (isq ? P.win_q_norm : P.win_k_norm) + l * 64 + lane_par * 32;
#pragma unroll
    for (int i = 0; i < 32; ++i) v[i] = v[i] * rstd * gn[i];
    if (isq) {
      if (samp) rope_axis16(v, ta, lane_par ? (ts & 63) : (ts >> 6));
      store32_bf16(Pb + PC_WQ + (cb - 1024), v);
    } else {
      int c = cb - 1280; int kvh = c >> 6;
      if (!samp) store32_f32(P.out + O_CWK + ((size_t)((pb * 2 + l) * 2 + kvh) * 256 + pt) * 64 + (c & 63), v);
      else rope_axis16(v, ta, lane_par ? (ts & 63) : (ts >> 6));
      store32_bf16(Pb + PC_WK + c, v);
    }
  } else if (cb < 1536) {
    int c = cb - 1408; int kvh = c >> 6;
    if (!samp) store32_f32(P.out + O_CWV + ((size_t)((pb * 2 + l) * 2 + kvh) * 256 + pt) * 64 + (c & 63), v);
#pragma unroll
    for (int i = 0; i < 32; ++i) VT[(size_t)(VH_WIN * 64 + c + i) * GT + ltok] = f2bf(v[i]);
  } else if (cb < 2048) {
    const bool isq = cb < 1792;
    float ss = 0.f;
#pragma unroll
    for (int i = 0; i < 32; ++i) ss += v[i] * v[i];
    float rstd = rsqrtf(ss * (1.f / 32.f) + EPS);
    const float* gn = (isq ? P.diff_q_norm : P.diff_k_norm) + l * 32;
#pragma unroll
    for (int i = 0; i < 32; ++i) v[i] = v[i] * rstd * gn[i];
    if (isq) {
      if (samp) rope_32(v, tb, ts >> 6, ts & 63);
      store32_bf16(Pb + PC_DQ + (cb - 1536), v);
    } else {
      int c = cb - 1792; int h = c >> 6, comp = (c >> 5) & 1;
      if (!samp) store32_f32(P.out + O_CDK + ((size_t)(((pb * 2 + l) * 4 + h) * 2 + comp) * 256 + pt) * 32, v);
      else rope_32(v, tb, ts >> 6, ts & 63);
      store32_bf16(Pb + PC_DK + c, v);
    }
  } else if (cb < 2304) {
    int c = cb - 2048; int h = c >> 6;
    if (!samp) store32_f32(P.out + O_CDV + ((size_t)((pb * 2 + l) * 4 + h) * 256 + pt) * 64 + (c & 63), v);
#pragma unroll
    for (int i = 0; i < 32; ++i) VT[(size_t)(VH_DIFF * 64 + c + i) * GT + ltok] = f2bf(v[i]);
  } else if (cb < 2560) {
    store32_bf16(Pb + PC_HQ + (cb - 2304), v);
  } else if (cb < 3072) {
    const int dir = cb >= 2816 ? 1 : 0; const int c = cb - (dir ? 2816 : 2560);
    float* LF = (float*)(P.ws + OFF_LF) + ((size_t)dir * GT + ltok) * 256 + c;
#pragma unroll
    for (int i = 0; i < 32; ++i) {
      float lb = 0.f;
      if (l == 1) { float a0 = P.hgrn_lb[(0 * 2 + dir) * 256 + c + i], a1 = P.hgrn_lb[(1 * 2 + dir) * 256 + c + i]; lb = 1.f / (1.f + __expf(a1 - a0)); }
      float sg = 1.f / (1.f + __expf(-v[i]));
      float f = lb + (1.f - lb) * sg;
      v[i] = __logf(fmaxf(f, 1e-30f));
    }
    store32_f32(LF, v);
  } else if (cb < 3328) {
    int c = cb - 3072;
#pragma unroll
    for (int i = 0; i < 32; ++i) VT[(size_t)(VH_HGRN * 64 + c + i) * GT + ltok] = f2bf(v[i]);
  } else {
#pragma unroll
    for (int i = 0; i < 32; ++i) v[i] = silu(v[i]);
    store32_bf16(Pb + PC_HG + (cb - 3328), v);
  }
}

template <int EPI>
DI void gemm_phase(const Params& P, int l, int g, char* smem) {
  const u16* A; const u16* B; int lda, ldb, K, N;
  if (EPI == EPI_IN) { A = (const u16*)(P.ws + OFF_HB); lda = 1024; B = (const u16*)(P.ws + OFF_WIN) + (size_t)l * 3584 * 1024; ldb = 1024; K = 1024; N = 3584; }
  else if (EPI == EPI_OUT) { A = (const u16*)(P.ws + OFF_HB); lda = 1024; B = (const u16*)(P.ws + OFF_WOUT) + (size_t)l * 1024 * 1024; ldb = 1024; K = 1024; N = 1024; }
  else if (EPI == EPI_FFN_IN) { A = (const u16*)(P.ws + OFF_HB); lda = 1024; B = (const u16*)(P.ws + OFF_WFI) + (size_t)l * 5632 * 1024; ldb = 1024; K = 1024; N = 5632; }
  else { A = (const u16*)(P.ws + OFF_PB); lda = 2816; B = (const u16*)(P.ws + OFF_WFO) + (size_t)l * 1024 * 2816; ldb = 2816; K = 2816; N = 1024; }
  const int ntn = N / 128, ntm = GT / 128, nk = K / 64;
  const int tid = get_tid(), lane = tid & 63, w = tid >> 6, wm = w >> 1, wn = w & 1, fr = lane & 15, fq = lane >> 4;
  const int wr_off = (tid >> 3) * 128 + (((tid & 7) ^ ((tid >> 3) & 7)) * 16);
  const float* mod = (const float*)(P.ws + OFF_MOD);
  for (int idx = blockIdx.x; idx < ntm * ntn; idx += gridDim.x) {
    const int m0 = (idx / ntn) * 128, n0 = (idx % ntn) * 128;
    f32x4 acc[4][4];
#pragma unroll
    for (int i = 0; i < 4; ++i)
#pragma unroll
      for (int j = 0; j < 4; ++j) acc[i][j] = (f32x4){0.f, 0.f, 0.f, 0.f};
    const u16* Ap = A + (size_t)(m0 + (tid >> 3)) * lda + (tid & 7) * 8;
    const u16* Bp = B + (size_t)(n0 + (tid >> 3)) * ldb + (tid & 7) * 8;
    uint4 ra[4], rb[4];
#pragma unroll
    for (int i = 0; i < 4; ++i) { ra[i] = *(const uint4*)(Ap + (size_t)(32 * i) * lda); rb[i] = *(const uint4*)(Bp + (size_t)(32 * i) * ldb); }
#pragma unroll
    for (int i = 0; i < 4; ++i) { *(uint4*)(smem + wr_off + i * 4096) = ra[i]; *(uint4*)(smem + 32768 + wr_off + i * 4096) = rb[i]; }
    __syncthreads();
    for (int kt = 0; kt < nk; ++kt) {
      const int cur = kt & 1;
      if (kt + 1 < nk) {
#pragma unroll
        for (int i = 0; i < 4; ++i) { ra[i] = *(const uint4*)(Ap + (size_t)(32 * i) * lda + (kt + 1) * 64); rb[i] = *(const uint4*)(Bp + (size_t)(32 * i) * ldb + (kt + 1) * 64); }
      }
      const char* sa = smem + cur * 16384; const char* sb = smem + 32768 + cur * 16384;
#pragma unroll
      for (int ks = 0; ks < 2; ++ks) {
        bf16x8 af[4], bfr[4];
        const int sw = ((ks * 4 + fq) ^ (fr & 7)) * 16;
#pragma unroll
        for (int i = 0; i < 4; ++i) { af[i] = *(const bf16x8*)(sa + (wm * 64 + i * 16 + fr) * 128 + sw); bfr[i] = *(const bf16x8*)(sb + (wn * 64 + i * 16 + fr) * 128 + sw); }
#pragma unroll
        for (int i = 0; i < 4; ++i)
#pragma unroll
          for (int j = 0; j < 4; ++j) acc[i][j] = MFMA(af[i], bfr[j], acc[i][j]);
      }
      if (kt + 1 < nk) {
        const int nx = cur ^ 1;
#pragma unroll
        for (int i = 0; i < 4; ++i) { *(uint4*)(smem + nx * 16384 + wr_off + i * 4096) = ra[i]; *(uint4*)(smem + 32768 + nx * 16384 + wr_off + i * 4096) = rb[i]; }
      }
      __syncthreads();
    }
    const int gtok0 = g * GT + m0;
    const int cond = cond_of(gtok0);
    if (EPI == EPI_OUT || EPI == EPI_FFN_OUT) {
      const float* gate = mod + (size_t)(l * 5 + cond) * 6144 + (EPI == EPI_OUT ? 2 : 5) * 1024;
#pragma unroll
      for (int i = 0; i < 4; ++i)
#pragma unroll
        for (int r = 0; r < 4; ++r) {
          const int gtok = gtok0 + wm * 64 + i * 16 + fq * 4 + r;
          const float* xin;
          if (EPI == EPI_OUT && l == 0) xin = gtok < NPT ? P.x_prompt + (size_t)gtok * 1024 : P.x_sample + (size_t)(gtok - NPT) * 1024;
          else xin = P.out + (size_t)gtok * 1024;
          float* xo = P.out + (size_t)gtok * 1024;
#pragma unroll
          for (int j = 0; j < 4; ++j) { const int col = n0 + wn * 64 + j * 16 + fr; xo[col] = xin[col] + gate[col] * acc[i][j][r]; }
        }
    } else if (EPI == EPI_FFN_IN) {
      u16* ACT = (u16*)(P.ws + OFF_PB);
#pragma unroll
      for (int i = 0; i < 4; ++i)
#pragma unroll
        for (int r = 0; r < 4; ++r) {
          const int ltok = m0 + wm * 64 + i * 16 + fq * 4 + r;
#pragma unroll
          for (int jp = 0; jp < 2; ++jp) {
            const int q = (n0 + wn * 64) / 32 + jp;
            float gv = acc[i][2 * jp][r], uv = acc[i][2 * jp + 1][r];
            ACT[(size_t)ltok * 2816 + q * 16 + fr] = f2bf(silu(gv) * uv);
          }
        }
    } else {
      float* st = (float*)smem;
#pragma unroll
      for (int pass = 0; pass < 2; ++pass) {
        if (wm == pass) {
#pragma unroll
          for (int i = 0; i < 4; ++i)
#pragma unroll
            for (int j = 0; j < 4; ++j)
#pragma unroll
              for (int r = 0; r < 4; ++r) {
                const int rl = i * 16 + fq * 4 + r, cl = wn * 64 + j * 16 + fr;
                st[rl * 144 + (cl >> 5) * 36 + (cl & 31)] = acc[i][j][r];
              }
        }
        __syncthreads();
        {
          const int row = tid >> 2, seg = tid & 3;
          float v[32];
#pragma unroll
          for (int i = 0; i < 8; ++i) { float4 t = *(const float4*)(st + row * 144 + seg * 36 + 4 * i); v[4 * i] = t.x; v[4 * i + 1] = t.y; v[4 * i + 2] = t.z; v[4 * i + 3] = t.w; }
          epi_in_segment(P, l, g, m0 + pass * 64 + row, n0 + seg * 32, v);
        }
        __syncthreads();
      }
    }
  }
}

template <int MODE>
DI void attn_item(const Params& P, int l, int g, int item, char* smem) {
  const int tid = get_tid(), lane = tid & 63, w = tid >> 6, fr = lane & 15, fq = lane >> 4;
  const u16* Pb = (const u16*)(P.ws + OFF_PB);
  const u16* VT = (const u16*)(P.ws + OFF_VT);
  u16* MIX = (u16*)(P.ws + OFF_HB);
  int sc, h, qb;
  if (MODE == 0) { sc = item >> 7; int r = item & 127; h = r & 3; qb = r >> 2; } else { sc = item >> 8; int r = item & 255; h = r & 3; qb = r >> 2; }
  const int gsc = g * 3 + sc; const bool samp = gsc >= 2; const int b = gsc - 2;
  const int QB = (MODE == 0) ? 128 : 64;
  const int ltq0 = sc * 4096 + qb * QB;
  int t0, kstart_l, nloc, nctx, kstart_t;
  if (samp) {
    t0 = qb * QB;
    if (MODE == 0) { kstart_t = t0 - 128 < 0 ? 0 : t0 - 128; int kend = t0 + 256 > 4096 ? 4096 : t0 + 256; nloc = (kend - kstart_t) >> 6; }
    else { kstart_t = 0; nloc = 64; }
    nctx = 8; kstart_l = sc * 4096 + kstart_t;
  } else { t0 = ltq0 & 255; kstart_t = 0; kstart_l = ltq0 & ~255; nloc = 4; nctx = 0; }
  const int ntile = nloc + nctx;
  const int kvhead = (MODE == 0) ? (VH_WIN + (h >> 1)) : (VH_DIFF + h);
  const int kcol = (MODE == 0) ? (PC_WK + (h >> 1) * 64) : (PC_DK + h * 64);
  const u16* ctxK; const u16* ctxV;
  if (MODE == 0) { ctxK = (const u16*)(P.ws + OFF_CWK) + (size_t)((l * 4 + b) * 2 + (h >> 1)) * 512 * 64; ctxV = (const u16*)(P.ws + OFF_CWVT) + (size_t)((l * 4 + b) * 2 + (h >> 1)) * 64 * 512; }
  else { ctxK = (const u16*)(P.ws + OFF_CDK) + (size_t)((l * 4 + b) * 4 + h) * 2 * 512 * 32; ctxV = (const u16*)(P.ws + OFF_CDVT) + (size_t)((l * 4 + b) * 4 + h) * 64 * 512; }
  const int comp = (MODE == 1) ? (w & 1) : 0;
  const int qoff = (MODE == 0) ? 32 * w : 32 * (w >> 1);
  bf16x8 qf[2][2];
#pragma unroll
  for (int qt = 0; qt < 2; ++qt) {
    const u16* qp = Pb + (size_t)(ltq0 + qoff + qt * 16 + fr) * PW;
    if (MODE == 0) { qf[qt][0] = *(const bf16x8*)(qp + PC_WQ + h * 64 + fq * 8); qf[qt][1] = *(const bf16x8*)(qp + PC_WQ + h * 64 + 32 + fq * 8); }
    else { qf[qt][0] = *(const bf16x8*)(qp + PC_DQ + h * 64 + comp * 32 + fq * 8); qf[qt][1] = qf[qt][0]; }
  }
  const float scl = (MODE == 0 ? 0.125f : 0.17677669529663687f) * LOG2E;
  float mrun[2], lrun[2];
  if (MODE == 0) { float sk = P.win_sink[l * 4 + h] * LOG2E; mrun[0] = mrun[1] = sk; lrun[0] = lrun[1] = (fq == 0) ? 1.f : 0.f; }
  else { mrun[0] = mrun[1] = -1e30f; lrun[0] = lrun[1] = 0.f; }
  f32x4 o[4][2];
#pragma unroll
  for (int i = 0; i < 4; ++i) { o[i][0] = (f32x4){0.f, 0.f, 0.f, 0.f}; o[i][1] = (f32x4){0.f, 0.f, 0.f, 0.f}; }
  char* sK = smem; char* sV = smem + 16384; float* sX = (float*)(smem + 16384 + 18432);
  uint4 rk0, rk1, rv0, rv1;
#define ATT_LOAD1(RK, RV, I, J) { \
      const int c_ = tid + 256 * (I); const int row_ = c_ >> 3, ch_ = c_ & 7; \
      if ((J) < nloc) { \
        const int key0_ = kstart_l + (J) * 64; \
        RK = *(const uint4*)(Pb + (size_t)(key0_ + row_) * PW + kcol + ch_ * 8); \
        RV = *(const uint4*)(VT + (size_t)(kvhead * 64 + row_) * GT + key0_ + ch_ * 8); \
      } else { \
        const int jc_ = (J) - nloc; \
        if (MODE == 0) RK = *(const uint4*)(ctxK + (size_t)(jc_ * 64 + row_) * 64 + ch_ * 8); \
        else RK = *(const uint4*)(ctxK + (size_t)(ch_ >> 2) * 512 * 32 + (size_t)(jc_ * 64 + row_) * 32 + (ch_ & 3) * 8); \
        RV = *(const uint4*)(ctxV + (size_t)row_ * 512 + jc_ * 64 + ch_ * 8); \
      } }
#define ATT_WRITE1(RK, RV, I, BUF) { \
      const int c_ = tid + 256 * (I); const int row_ = c_ >> 3, ch_ = c_ & 7; \
      *(uint4*)(sK + (BUF) * 8192 + row_ * 128 + ((ch_ ^ (row_ & 7)) * 16)) = RK; \
      *(uint4*)(sV + (BUF) * 9216 + row_ * 144 + ch_ * 16) = RV; }
#define load_tile(J) { ATT_LOAD1(rk0, rv0, 0, J) ATT_LOAD1(rk1, rv1, 1, J) }
#define write_tile(BUF) { ATT_WRITE1(rk0, rv0, 0, BUF) ATT_WRITE1(rk1, rv1, 1, BUF) }
  __syncthreads();
  load_tile(0); write_tile(0);
  __syncthreads();
  for (int j = 0; j < ntile; ++j) {
    const int cur = j & 1;
    if (j + 1 < ntile) load_tile(j + 1);
    const char* kb = sK + cur * 8192; const char* vb = sV + cur * 9216;
    f32x4 s[4][2];
#pragma unroll
    for (int kt = 0; kt < 4; ++kt) {
      s[kt][0] = (f32x4){0.f, 0.f, 0.f, 0.f}; s[kt][1] = (f32x4){0.f, 0.f, 0.f, 0.f};
      if (MODE == 0) {
#pragma unroll
        for (int ks = 0; ks < 2; ++ks) {
          bf16x8 a = *(const bf16x8*)(kb + (kt * 16 + fr) * 128 + (((ks * 4 + fq) ^ (fr & 7)) * 16));
          s[kt][0] = MFMA(a, qf[0][ks], s[kt][0]); s[kt][1] = MFMA(a, qf[1][ks], s[kt][1]);
        }
      } else {
        bf16x8 a = *(const bf16x8*)(kb + (kt * 16 + fr) * 128 + (((comp * 4 + fq) ^ (fr & 7)) * 16));
        s[kt][0] = MFMA(a, qf[0][0], s[kt][0]); s[kt][1] = MFMA(a, qf[1][0], s[kt][1]);
      }
    }
    const bool domask = (MODE == 0) && samp && (j < nloc);
    bf16x8 pb[2][2];
#pragma unroll
    for (int qt = 0; qt < 2; ++qt) {
      float mx = -1e30f;
#pragma unroll
      for (int kt = 0; kt < 4; ++kt)
#pragma unroll
        for (int r = 0; r < 4; ++r) {
          float v = s[kt][qt][r] * scl;
          if (domask) { int tk = kstart_t + j * 64 + kt * 16 + fq * 4 + r; int tq = t0 + qoff + qt * 16 + fr; int d = tq - tk; if (d > 128 || d < -128) v = -1e30f; }
          s[kt][qt][r] = v; mx = fmaxf(mx, v);
        }
      mx = fmaxf(mx, __shfl_xor(mx, 16)); mx = fmaxf(mx, __shfl_xor(mx, 32));
      const float mnew = fmaxf(mrun[qt], mx);
      const float alpha = exp2f(mrun[qt] - mnew);
      mrun[qt] = mnew;
      float ls = 0.f;
#pragma unroll
      for (int kt = 0; kt < 4; ++kt)
#pragma unroll
        for (int r = 0; r < 4; ++r) { float p = exp2f(s[kt][qt][r] - mnew); s[kt][qt][r] = p; ls += p; }
      lrun[qt] = lrun[qt] * alpha + ls;
#pragma unroll
      for (int mt = 0; mt < 4; ++mt) o[mt][qt] *= alpha;
#pragma unroll
      for (int kk = 0; kk < 2; ++kk) {
        union { bf16x8 v; unsigned u[4]; } pk;
        pk.u[0] = pack2(s[2 * kk][qt][0], s[2 * kk][qt][1]); pk.u[1] = pack2(s[2 * kk][qt][2], s[2 * kk][qt][3]);
        pk.u[2] = pack2(s[2 * kk + 1][qt][0], s[2 * kk + 1][qt][1]); pk.u[3] = pack2(s[2 * kk + 1][qt][2], s[2 * kk + 1][qt][3]);
        pb[qt][kk] = pk.v;
      }
    }
#pragma unroll
    for (int kk = 0; kk < 2; ++kk)
#pragma unroll
      for (int mt = 0; mt < 4; ++mt) {
        s16x4 lo = *(const s16x4*)(vb + (mt * 16 + fr) * 144 + (kk * 32 + fq * 4) * 2);
        s16x4 hi = *(const s16x4*)(vb + (mt * 16 + fr) * 144 + (kk * 32 + 16 + fq * 4) * 2);
        bf16x8 a = __builtin_shufflevector(lo, hi, 0, 1, 2, 3, 4, 5, 6, 7);
        o[mt][0] = MFMA(a, pb[0][kk], o[mt][0]); o[mt][1] = MFMA(a, pb[1][kk], o[mt][1]);
      }
    if (j + 1 < ntile) write_tile(cur ^ 1);
    __syncthreads();
  }
#pragma unroll
  for (int qt = 0; qt < 2; ++qt) {
    float lt = lrun[qt]; lt += __shfl_xor(lt, 16); lt += __shfl_xor(lt, 32);
    const float inv = 1.f / lt;
#pragma unroll
    for (int mt = 0; mt < 4; ++mt) o[mt][qt] *= inv;
  }
  if (MODE == 0) {
#pragma unroll
    for (int qt = 0; qt < 2; ++qt) {
      u16* dst = MIX + (size_t)(ltq0 + qoff + qt * 16 + fr) * 1024 + 256 + h * 64;
#pragma unroll
      for (int mt = 0; mt < 4; ++mt) { uint2 v; v.x = pack2(o[mt][qt][0], o[mt][qt][1]); v.y = pack2(o[mt][qt][2], o[mt][qt][3]); *(uint2*)(dst + mt * 16 + fq * 4) = v; }
    }
  } else {
    float* xb = sX + (w >> 1) * (32 * 68);
    if (comp == 1) {
#pragma unroll
      for (int qt = 0; qt < 2; ++qt)
#pragma unroll
        for (int mt = 0; mt < 4; ++mt) *(float4*)(xb + (qt * 16 + fr) * 68 + mt * 16 + fq * 4) = make_float4(o[mt][qt][0], o[mt][qt][1], o[mt][qt][2], o[mt][qt][3]);
    }
    __syncthreads();
    if (comp == 0) {
      float d1 = 0.f, d2 = 0.f;
      const float* dl = P.diff_lambda + l * 128;
#pragma unroll
      for (int i = 0; i < 32; ++i) { d1 += dl[i] * dl[32 + i]; d2 += dl[64 + i] * dl[96 + i]; }
      const float lam_init = 0.8f - 0.6f * __expf(-0.3f * (float)l);
      const float lam = __expf(d1) - __expf(d2) + lam_init;
#pragma unroll
      for (int qt = 0; qt < 2; ++qt) {
        float ss = 0.f;
#pragma unroll
        for (int mt = 0; mt < 4; ++mt) {
          float4 o2 = *(const float4*)(xb + (qt * 16 + fr) * 68 + mt * 16 + fq * 4);
          o[mt][qt][0] -= lam * o2.x; o[mt][qt][1] -= lam * o2.y; o[mt][qt][2] -= lam * o2.z; o[mt][qt][3] -= lam * o2.w;
#pragma unroll
          for (int r = 0; r < 4; ++r) ss += o[mt][qt][r] * o[mt][qt][r];
        }
        ss += __shfl_xor(ss, 16); ss += __shfl_xor(ss, 32);
        const float rs = rsqrtf(ss * (1.f / 64.f) + EPS) * (1.f - lam_init);
        u16* dst = MIX + (size_t)(ltq0 + qoff + qt * 16 + fr) * 1024 + 512 + h * 64;
#pragma unroll
        for (int mt = 0; mt < 4; ++mt) {
          float4 gn = *(const float4*)(P.diff_norm_g + l * 256 + h * 64 + mt * 16 + fq * 4);
          uint2 v; v.x = pack2(o[mt][qt][0] * rs * gn.x, o[mt][qt][1] * rs * gn.y); v.y = pack2(o[mt][qt][2] * rs * gn.z, o[mt][qt][3] * rs * gn.w);
          *(uint2*)(dst + mt * 16 + fq * 4) = v;
        }
      }
    }
  }
}

#undef load_tile
#undef write_tile
DI void gla_state_item(const Params& P, int l, int g, int stream, int chunk, int h, char* smem) {
  const int tid = get_tid(), lane = tid & 63, w = tid >> 6, fr = lane & 15, fq = lane >> 4;
  const u16* Pb = (const u16*)(P.ws + OFF_PB);
  const u16* VT = (const u16*)(P.ws + OFF_VT);
  const float* LF = (const float*)(P.ws + OFF_LF);
  u16* sV = (u16*)smem; float* sCf = (float*)(smem + 9216); float* sCb = (float*)(smem + 26624); u16* sKf = (u16*)(smem + 44032); u16* sKb = (u16*)(smem + 53248);
  const int ltok0 = chunk * 64;
  const int vh = (stream == 0 ? VH_RET : VH_HGRN) + h;
  __syncthreads();
#pragma unroll
  for (int i = 0; i < 2; ++i) { const int c = tid + 256 * i; const int dv = c >> 3, ch = c & 7; *(uint4*)((char*)sV + dv * 144 + ch * 16) = *(const uint4*)(VT + (size_t)(vh * 64 + dv) * GT + ltok0 + ch * 8); }
  if (stream == 0) {
    const float lgf = -__expf(P.ret_decay[(l * 2 + 0) * 4 + h]), lgb = -__expf(P.ret_decay[(l * 2 + 1) * 4 + h]);
#pragma unroll
    for (int i = 0; i < 16; ++i) { const int e = tid + 256 * i; const int s = e >> 6, d = e & 63; sCf[s * 68 + d] = (float)(s + 1) * lgf; sCb[s * 68 + d] = (float)(s + 1) * lgb; }
    __syncthreads();
  } else {
#pragma unroll
    for (int i = 0; i < 4; ++i) {
      const int c = tid + 256 * i; const int s = c >> 4, d4 = (c & 15) * 4;
      *(float4*)(sCf + s * 68 + d4) = *(const float4*)(LF + ((size_t)0 * GT + ltok0 + s) * 256 + h * 64 + d4);
      *(float4*)(sCb + s * 68 + d4) = *(const float4*)(LF + ((size_t)1 * GT + ltok0 + s) * 256 + h * 64 + d4);
    }
    __syncthreads();
    const int d = tid & 63, part = tid >> 6;
    float af = 0.f, ab = 0.f;
#pragma unroll
    for (int i = 0; i < 16; ++i) { const int s = part * 16 + i; af += sCf[s * 68 + d]; sCf[s * 68 + d] = af; ab += sCb[s * 68 + d]; sCb[s * 68 + d] = ab; }
    __syncthreads();
    float of = 0.f, ob = 0.f;
    for (int p = 0; p < part; ++p) { of += sCf[(p * 16 + 15) * 68 + d]; ob += sCb[(p * 16 + 15) * 68 + d]; }
    __syncthreads();
#pragma unroll
    for (int i = 0; i < 16; ++i) { const int s = part * 16 + i; sCf[s * 68 + d] += of; sCb[s * 68 + d] += ob; }
    __syncthreads();
  }
  {
    const int s = tid & 63, db = (tid >> 6) * 16;
    const u16* kp = Pb + (size_t)(ltok0 + s) * PW + PC_RK + h * 64 + db;
#pragma unroll
    for (int i = 0; i < 16; ++i) {
      const int d = db + i;
      const float cf = sCf[s * 68 + d], cfp = s > 0 ? sCf[(s - 1) * 68 + d] : 0.f, lastf = sCf[63 * 68 + d];
      const float cbv = sCb[s * 68 + d], cbp = s > 0 ? sCb[(s - 1) * 68 + d] : 0.f;
      float kf, kb;
      if (stream == 0) { kf = bf2f(kp[i]); kb = kf; } else { kf = 1.f - __expf(cf - cfp); kb = 1.f - __expf(cbv - cbp); }
      sKf[d * 72 + s] = f2bf(kf * __expf(lastf - cf));
      sKb[d * 72 + s] = f2bf(kb * __expf(cbp));
    }
  }
  __syncthreads();
  float* ST = (float*)(P.ws + OFF_ST); float* DEC = (float*)(P.ws + OFF_DEC);
#pragma unroll
  for (int dir = 0; dir < 2; ++dir) {
    const u16* sK = dir ? sKb : sKf;
    float* dst = ST + ((size_t)((stream * NCH + chunk) * 2 + dir) * 4 + h) * 4096;
#pragma unroll
    for (int nt = 0; nt < 4; ++nt) {
      f32x4 acc = (f32x4){0.f, 0.f, 0.f, 0.f};
#pragma unroll
      for (int ks = 0; ks < 2; ++ks) {
        bf16x8 a = *(const bf16x8*)((const char*)sV + (16 * w + fr) * 144 + (ks * 4 + fq) * 16);
        bf16x8 bb = *(const bf16x8*)((const char*)sK + (nt * 16 + fr) * 144 + (ks * 4 + fq) * 16);
        acc = MFMA(a, bb, acc);
      }
#pragma unroll
      for (int r = 0; r < 4; ++r) dst[(16 * w + fq * 4 + r) * 64 + nt * 16 + fr] = acc[r];
    }
  }
  if (tid < 128) {
    const int dir = tid >> 6, d = tid & 63;
    DEC[((size_t)((stream * NCH + chunk) * 2 + dir) * 4 + h) * 64 + d] = __expf((dir ? sCb : sCf)[63 * 68 + d]);
  }
}

DI void scan_phase(const Params& P, int l, int g) {
  const int tid = get_tid();
  const int nseq = (g == 0) ? 33 : 3;
  float* ST = (float*)(P.ws + OFF_ST); const float* DEC = (const float*)(P.ws + OFF_DEC);
  for (int it = blockIdx.x; it < nseq * 256; it += gridDim.x) {
    const int sl = it >> 8, r = it & 255;
    const int stream = r >> 7, dir = (r >> 6) & 1, h = (r >> 4) & 3, slice = r & 15;
    const int e = slice * 256 + tid; const int dv = e >> 6, dk = e & 63;
    int chunk0, nch, b; bool samp;
    if (g == 0) { if (sl < 32) { samp = false; b = sl; chunk0 = sl * 4; nch = 4; } else { samp = true; b = 0; chunk0 = 128; nch = 64; } }
    else { samp = true; b = 1 + sl; chunk0 = sl * 64; nch = 64; }
    float s = 0.f;
    if (samp) { const float* s0 = (stream == 0 ? P.state_ret : P.state_hgrn); s = s0[((size_t)((b * 2 + l) * 2 + dir) * 4 + h) * 4096 + dk * 64 + dv]; }
    for (int c0 = 0; c0 < nch; c0 += 4) {
      float u[4], d[4]; size_t idx[4];
#pragma unroll
      for (int q = 0; q < 4; ++q) {
        const int ci = c0 + q; const int c = dir == 0 ? chunk0 + ci : chunk0 + nch - 1 - ci;
        const size_t base = (size_t)((stream * NCH + c) * 2 + dir) * 4 + h;
        idx[q] = base * 4096 + e; u[q] = ST[idx[q]]; d[q] = DEC[base * 64 + dk];
      }
#pragma unroll
      for (int q = 0; q < 4; ++q) { ST[idx[q]] = s; s = d[q] * s + u[q]; }
    }
    if (!samp) { float* so = P.out + (stream == 0 ? O_SRET : O_SHG); so[((size_t)((b * 2 + l) * 2 + dir) * 4 + h) * 4096 + dk * 64 + dv] = s; }
  }
}

DI void gla_out_item(const Params& P, int l, int g, int stream, int chunk, int h, char* smem) {
  const int tid = get_tid(), lane = tid & 63, w = tid >> 6, fr = lane & 15, fq = lane >> 4;
  const u16* Pb = (const u16*)(P.ws + OFF_PB);
  const u16* VT = (const u16*)(P.ws + OFF_VT);
  const float* LF = (const float*)(P.ws + OFF_LF);
  const float* ST = (const float*)(P.ws + OFF_ST);
  u16* MIX = (u16*)(P.ws + OFF_HB);
  char* sQ = smem; char* sK = smem + 8192; float* sC = (float*)(smem + 16384); char* sV = smem + 33792; char* sS = smem + 43008;
  const int ltok0 = chunk * 64;
  const int qcol = (stream == 0 ? PC_RQ : PC_HQ) + h * 64, gcol = (stream == 0 ? PC_RG : PC_HG) + h * 64;
  const int vh = (stream == 0 ? VH_RET : VH_HGRN) + h;
  f32x4 of[4];
#pragma unroll
  for (int i = 0; i < 4; ++i) of[i] = (f32x4){0.f, 0.f, 0.f, 0.f};
#pragma unroll 1
  for (int pass = 0; pass < 2; ++pass) {
    __syncthreads();
#pragma unroll
    for (int i = 0; i < 2; ++i) {
      const int c = tid + 256 * i; const int row = c >> 3, ch = c & 7;
      const int tok = pass ? ltok0 + 63 - row : ltok0 + row;
      *(uint4*)(sQ + row * 128 + ((ch ^ (row & 7)) * 16)) = *(const uint4*)(Pb + (size_t)tok * PW + qcol + ch * 8);
      if (stream == 0) *(uint4*)(sK + row * 128 + ((ch ^ (row & 7)) * 16)) = *(const uint4*)(Pb + (size_t)tok * PW + PC_RK + h * 64 + ch * 8);
      uint4 vv = *(const uint4*)(VT + (size_t)(vh * 64 + row) * GT + ltok0 + ch * 8);
      if (pass) {
        uint4 t;
        t.x = (vv.w >> 16) | (vv.w << 16); t.y = (vv.z >> 16) | (vv.z << 16); t.z = (vv.y >> 16) | (vv.y << 16); t.w = (vv.x >> 16) | (vv.x << 16);
        *(uint4*)(sV + row * 144 + (7 - ch) * 16) = t;
      } else *(uint4*)(sV + row * 144 + ch * 16) = vv;
    }
    {
      const int dv = tid >> 2, part = tid & 3;
      const float* sp = ST + ((size_t)((stream * NCH + chunk) * 2 + pass) * 4 + h) * 4096 + dv * 64 + part * 16;
      float t[16];
#pragma unroll
      for (int i = 0; i < 4; ++i) { float4 f = *(const float4*)(sp + 4 * i); t[4 * i] = f.x; t[4 * i + 1] = f.y; t[4 * i + 2] = f.z; t[4 * i + 3] = f.w; }
#pragma unroll
      for (int hh = 0; hh < 2; ++hh) {
        uint4 o4; o4.x = pack2(t[8 * hh], t[8 * hh + 1]); o4.y = pack2(t[8 * hh + 2], t[8 * hh + 3]); o4.z = pack2(t[8 * hh + 4], t[8 * hh + 5]); o4.w = pack2(t[8 * hh + 6], t[8 * hh + 7]);
        const int ch = part * 2 + hh;
        *(uint4*)(sS + dv * 128 + ((ch ^ (dv & 7)) * 16)) = o4;
      }
    }
    if (stream == 0) {
      const float lg = -__expf(P.ret_decay[(l * 2 + pass) * 4 + h]);
#pragma unroll
      for (int i = 0; i < 16; ++i) { const int e = tid + 256 * i; const int s = e >> 6, d = e & 63; sC[s * 68 + d] = (float)(s + 1) * lg; }
      __syncthreads();
    } else {
#pragma unroll
      for (int i = 0; i < 4; ++i) {
        const int c = tid + 256 * i; const int row = c >> 4, d4 = (c & 15) * 4;
        const int tok = pass ? ltok0 + 63 - row : ltok0 + row;
        *(float4*)(sC + row * 68 + d4) = *(const float4*)(LF + ((size_t)pass * GT + tok) * 256 + h * 64 + d4);
      }
      __syncthreads();
      {
        const int row = tid >> 2, part = tid & 3;
        float t[16];
#pragma unroll
        for (int i = 0; i < 16; ++i) t[i] = 1.f - __expf(sC[row * 68 + part * 16 + i]);
#pragma unroll
        for (int hh = 0; hh < 2; ++hh) {
          uint4 o4; o4.x = pack2(t[8 * hh], t[8 * hh + 1]); o4.y = pack2(t[8 * hh + 2], t[8 * hh + 3]); o4.z = pack2(t[8 * hh + 4], t[8 * hh + 5]); o4.w = pack2(t[8 * hh + 6], t[8 * hh + 7]);
          const int ch = part * 2 + hh;
          *(uint4*)(sK + row * 128 + ((ch ^ (row & 7)) * 16)) = o4;
        }
      }
      __syncthreads();
      const int d = tid & 63, part = tid >> 6;
      float a = 0.f;
#pragma unroll
      for (int i = 0; i < 16; ++i) { const int s = part * 16 + i; a += sC[s * 68 + d]; sC[s * 68 + d] = a; }
      __syncthreads();
      float off = 0.f;
      for (int p = 0; p < part; ++p) off += sC[(p * 16 + 15) * 68 + d];
      __syncthreads();
#pragma unroll
      for (int i = 0; i < 16; ++i) { const int s = part * 16 + i; sC[s * 68 + d] += off; }
      __syncthreads();
    }
    const int j = pass ? 3 - w : w;
    const int rowq = 16 * j + fr;
    bf16x8 qB[2], qI[2];
    float cj[2][8];
#pragma unroll
    for (int ks = 0; ks < 2; ++ks) {
      const int d0 = ks * 32 + fq * 8;
      bf16x8 q8 = *(const bf16x8*)(sQ + rowq * 128 + (((ks * 4 + fq) ^ (rowq & 7)) * 16));
      float4 c0 = *(const float4*)(sC + rowq * 68 + d0), c1 = *(const float4*)(sC + rowq * 68 + d0 + 4);
      float cq[8] = {c0.x, c0.y, c0.z, c0.w, c1.x, c1.y, c1.z, c1.w};
      if (j > 0) {
        float4 j0 = *(const float4*)(sC + (16 * j - 1) * 68 + d0), j1 = *(const float4*)(sC + (16 * j - 1) * 68 + d0 + 4);
        cj[ks][0] = j0.x; cj[ks][1] = j0.y; cj[ks][2] = j0.z; cj[ks][3] = j0.w; cj[ks][4] = j1.x; cj[ks][5] = j1.y; cj[ks][6] = j1.z; cj[ks][7] = j1.w;
      } else {
#pragma unroll
        for (int e = 0; e < 8; ++e) cj[ks][e] = 0.f;
      }
      union { bf16x8 v; unsigned u[4]; } ub, ui;
#pragma unroll
      for (int e = 0; e < 4; ++e) {
        float q0 = bf2f((u16)q8[2 * e]), q1 = bf2f((u16)q8[2 * e + 1]);
        ub.u[e] = pack2(q0 * __expf(cq[2 * e] - cj[ks][2 * e]), q1 * __expf(cq[2 * e + 1] - cj[ks][2 * e + 1]));
        ui.u[e] = pack2(q0 * __expf(cq[2 * e]), q1 * __expf(cq[2 * e + 1]));
      }
      qB[ks] = ub.v; qI[ks] = ui.v;
    }
    f32x4 st[4];
#pragma unroll
    for (int i = 0; i < 4; ++i) {
      st[i] = (f32x4){0.f, 0.f, 0.f, 0.f};
      if (i <= j) {
        const int rowk = 16 * i + fr;
#pragma unroll
        for (int ks = 0; ks < 2; ++ks) {
          const int d0 = ks * 32 + fq * 8;
          bf16x8 k8 = *(const bf16x8*)(sK + rowk * 128 + (((ks * 4 + fq) ^ (rowk & 7)) * 16));
          float4 c0 = *(const float4*)(sC + rowk * 68 + d0), c1 = *(const float4*)(sC + rowk * 68 + d0 + 4);
          float ck[8] = {c0.x, c0.y, c0.z, c0.w, c1.x, c1.y, c1.z, c1.w};
          union { bf16x8 v; unsigned u[4]; } ua;
#pragma unroll
          for (int e = 0; e < 4; ++e) {
            float k0 = bf2f((u16)k8[2 * e]), k1 = bf2f((u16)k8[2 * e + 1]);
            ua.u[e] = pack2(k0 * __expf(fminf(cj[ks][2 * e] - ck[2 * e], 80.f)), k1 * __expf(fminf(cj[ks][2 * e + 1] - ck[2 * e + 1], 80.f)));
          }
          st[i] = MFMA(ua.v, qB[ks], st[i]);
        }
        if (i == j) {
#pragma unroll
          for (int r = 0; r < 4; ++r) if (fq * 4 + r > fr) st[i][r] = 0.f;
        }
      }
    }
    f32x4 o[4];
#pragma unroll
    for (int i = 0; i < 4; ++i) o[i] = (f32x4){0.f, 0.f, 0.f, 0.f};
#pragma unroll
    for (int kk = 0; kk < 2; ++kk) {
      if (2 * kk <= j) {
        union { bf16x8 v; unsigned u[4]; } pk;
        pk.u[0] = pack2(st[2 * kk][0], st[2 * kk][1]); pk.u[1] = pack2(st[2 * kk][2], st[2 * kk][3]);
        pk.u[2] = pack2(st[2 * kk + 1][0], st[2 * kk + 1][1]); pk.u[3] = pack2(st[2 * kk + 1][2], st[2 * kk + 1][3]);
#pragma unroll
        for (int mt = 0; mt < 4; ++mt) {
          s16x4 lo = *(const s16x4*)(sV + (mt * 16 + fr) * 144 + (kk * 32 + fq * 4) * 2);
          s16x4 hi = *(const s16x4*)(sV + (mt * 16 + fr) * 144 + (kk * 32 + 16 + fq * 4) * 2);
          bf16x8 a = __builtin_shufflevector(lo, hi, 0, 1, 2, 3, 4, 5, 6, 7);
          o[mt] = MFMA(a, pk.v, o[mt]);
        }
      }
    }
#pragma unroll
    for (int ks = 0; ks < 2; ++ks)
#pragma unroll
      for (int mt = 0; mt < 4; ++mt) {
        const int rs = mt * 16 + fr;
        bf16x8 a = *(const bf16x8*)(sS + rs * 128 + (((ks * 4 + fq) ^ (rs & 7)) * 16));
        o[mt] = MFMA(a, qI[ks], o[mt]);
      }
    if (pass == 0) {
#pragma unroll
      for (int mt = 0; mt < 4; ++mt) of[mt] = o[mt];
    } else {
      const int srcl = (lane & 48) | (15 - fr);
#pragma unroll
      for (int mt = 0; mt < 4; ++mt)
#pragma unroll
        for (int r = 0; r < 4; ++r) of[mt][r] += __shfl(o[mt][r], srcl);
    }
  }
  const int tok = ltok0 + 16 * w + fr;
  float ss = 0.f;
#pragma unroll
  for (int mt = 0; mt < 4; ++mt)
#pragma unroll
    for (int r = 0; r < 4; ++r) ss += of[mt][r] * of[mt][r];
  ss += __shfl_xor(ss, 16); ss += __shfl_xor(ss, 32);
  const float rs = rsqrtf(ss * (1.f / 64.f) + EPS);
  const float* gnp = (stream == 0 ? P.ret_norm_g : P.hgrn_norm_g) + l * 256 + h * 64;
  u16* dst = MIX + (size_t)tok * 1024 + (stream == 0 ? 0 : 768) + h * 64;
#pragma unroll
  for (int mt = 0; mt < 4; ++mt) {
    const int dv = mt * 16 + fq * 4;
    float4 gn = *(const float4*)(gnp + dv);
    uint2 gt = *(const uint2*)(Pb + (size_t)tok * PW + gcol + dv);
    float g0 = bf2f((u16)(gt.x & 0xffff)), g1 = bf2f((u16)(gt.x >> 16)), g2 = bf2f((u16)(gt.y & 0xffff)), g3 = bf2f((u16)(gt.y >> 16));
    uint2 v; v.x = pack2(of[mt][0] * rs * gn.x * g0, of[mt][1] * rs * gn.y * g1); v.y = pack2(of[mt][2] * rs * gn.z * g2, of[mt][3] * rs * gn.w * g3);
    *(uint2*)(dst + dv) = v;
  }
}

DI void mix1_phase(const Params& P, int l, int g, char* smem) {
  constexpr int N_DIFF = 768, N_WIN = 384, N_ST = 2 * NCH * 4;
  for (int it = blockIdx.x; it < N_DIFF + N_WIN + N_ST; it += gridDim.x) {
    if (it < N_DIFF) attn_item<1>(P, l, g, it, smem);
    else if (it < N_DIFF + N_WIN) attn_item<0>(P, l, g, it - N_DIFF, smem);
    else { int r = it - N_DIFF - N_WIN; int stream = r / (NCH * 4); int rr = r % (NCH * 4); gla_state_item(P, l, g, stream, rr >> 2, rr & 3, smem); }
  }
}
DI void mix3_phase(const Params& P, int l, int g, char* smem) {
  for (int it = blockIdx.x; it < 2 * NCH * 4; it += gridDim.x) { int stream = it / (NCH * 4); int rr = it % (NCH * 4); gla_out_item(P, l, g, stream, rr >> 2, rr & 3, smem); }
}

#define XB_TMO      128
#define XB_XCNT(j)  (256  + 64 * (j))
#define XB_XSUB(j)  (1280 + 64 * (j))
#define XB_XGEN(j)  (2304 + 64 * (j))
#define XB_TOP      3328
#define XB_TOPGEN   3392
#define XCD_BAR_WORDS 3456
#define XB_SPIN_CAP (1u << 22)
#define LAS __attribute__((address_space(3)))
DI unsigned xb_ld(unsigned* p) { return __hip_atomic_load(p, __ATOMIC_RELAXED, __HIP_MEMORY_SCOPE_AGENT); }
DI unsigned xb_add(unsigned* p, unsigned v) { return __hip_atomic_fetch_add(p, v, __ATOMIC_RELAXED, __HIP_MEMORY_SCOPE_AGENT); }
DI unsigned xb_xcc_id() { return (unsigned)__builtin_amdgcn_s_getreg((3 << 11) | 20) & 0xFu; }
#define XB_SPIN(cond, bar) do { unsigned _sp = 0; while (cond) { __builtin_amdgcn_s_sleep(1); \
    if ((++_sp & 255u) == 0u) { if (xb_ld(&(bar)[XB_TMO])) break; if (_sp > XB_SPIN_CAP) { atomicAdd(&(bar)[XB_TMO], 1u); break; } } } } while (0)
struct XcdBarrier { unsigned* bar; unsigned x; volatile LAS unsigned* st; };
DI XcdBarrier xcd_barrier_post(unsigned* bar, volatile LAS unsigned* st) {
  XcdBarrier b; b.bar = bar; b.x = xb_xcc_id(); b.st = st;
  if (threadIdx.x == 0) (void)xb_add(&bar[XB_XCNT(b.x)], 1u);
  return b;
}
DI void xcd_barrier_complete(unsigned* bar, unsigned x, unsigned& nloc, unsigned& nx) {
  const unsigned G = gridDim.x * gridDim.y * gridDim.z;
  unsigned sum, cnt, mine, sp = 0u;
  for (;;) {
    sum = 0u; cnt = 0u; mine = 0u;
#pragma unroll
    for (unsigned j = 0; j < 16; ++j) { const unsigned c = xb_ld(&bar[XB_XCNT(j)]); sum += c; cnt += (c > 0u) ? 1u : 0u; mine = (j == x) ? c : mine; }
    if (sum == G) break;
    __builtin_amdgcn_s_sleep(1);
    if ((++sp & 255u) == 0u) { if (xb_ld(&bar[XB_TMO])) break; if (sp > XB_SPIN_CAP) { atomicAdd(&bar[XB_TMO], 1u); break; } }
  }
  nloc = mine > 0u ? mine : 1u; nx = cnt > 0u ? cnt : 1u;
}
DI void xcd_barrier(const XcdBarrier& b) {
  asm volatile("s_waitcnt vmcnt(0)" ::: "memory");
  __syncthreads();
  if (threadIdx.x == 0) {
    unsigned* bar = b.bar;
    __builtin_amdgcn_s_waitcnt(0);
    unsigned nloc = b.st[0], nx = b.st[1];
    if (nloc == 0u) { xcd_barrier_complete(bar, b.x, nloc, nx); b.st[0] = nloc; b.st[1] = nx; }
    const unsigned old = xb_add(&bar[XB_XSUB(b.x)], 1u);
    const unsigned gen = old / nloc;
    if (old + 1u == (gen + 1u) * nloc) {
      __builtin_amdgcn_fence(__ATOMIC_RELEASE, "agent");
      asm volatile("s_waitcnt vmcnt(0)" ::: "memory");
      const unsigned og = xb_add(&bar[XB_TOP], 1u);
      const unsigned tg = og / nx;
      if (og + 1u == (tg + 1u) * nx) xb_add(&bar[XB_TOPGEN], 1u);
      else XB_SPIN(xb_ld(&bar[XB_TOPGEN]) == tg, bar);
      __builtin_amdgcn_fence(__ATOMIC_ACQUIRE, "agent");
      xb_add(&bar[XB_XGEN(b.x)], 1u);
      asm volatile("s_waitcnt vmcnt(0)" ::: "memory");
    } else {
      XB_SPIN(xb_ld(&bar[XB_XGEN(b.x)]) == gen, bar);
      __builtin_amdgcn_fence(__ATOMIC_ACQUIRE, "agent");
      asm volatile("s_waitcnt vmcnt(0)" ::: "memory");
    }
  }
  __syncthreads();
}

__global__ void __launch_bounds__(256, 2) hybrid_megakernel(Params P) {
  __shared__ __attribute__((aligned(16))) char smem[65536];
  __shared__ uint4 xb_words;
  cg::grid_group grid = cg::this_grid();
  if (threadIdx.x == 0) xb_words = make_uint4(0u, 0u, 0u, 0u);
  __syncthreads();
  XcdBarrier xb = xcd_barrier_post((unsigned*)P.ws, (volatile LAS unsigned*)&xb_words);
  prep_phase(P, smem);
  grid.sync();
  for (int l = 0; l < 2; ++l) {
    for (int g = 0; g < NGROUP; ++g) {
      norm_phase(P, l, g, 0);
      xcd_barrier(xb);
      gemm_phase<EPI_IN>(P, l, g, smem);
      xcd_barrier(xb);
      mix1_phase(P, l, g, smem);
      xcd_barrier(xb);
      scan_phase(P, l, g);
      xcd_barrier(xb);
      mix3_phase(P, l, g, smem);
      xcd_barrier(xb);
      gemm_phase<EPI_OUT>(P, l, g, smem);
      xcd_barrier(xb);
      norm_phase(P, l, g, 1);
      xcd_barrier(xb);
      gemm_phase<EPI_FFN_IN>(P, l, g, smem);
      xcd_barrier(xb);
      gemm_phase<EPI_FFN_OUT>(P, l, g, smem);
    }
  }
}

extern "C" void kernel_launch(void* const* d_in, const int* in_sizes, int n_in, void* d_out, int out_size, void* d_ws, size_t ws_size,
                              hipStream_t stream) {
  static int grid_blocks = 0;
  if (!grid_blocks) {
    int dev = 0, cus = 0, per_cu = 0;
    hipGetDevice(&dev);
    hipDeviceGetAttribute(&cus, hipDeviceAttributeMultiprocessorCount, dev);
    hipOccupancyMaxActiveBlocksPerMultiprocessor(&per_cu, hybrid_megakernel, 256, 0);
    if (per_cu > 2) per_cu = 2;
    if (per_cu < 1) per_cu = 1;
    grid_blocks = cus * per_cu;
  }
  if (ws_size < WS_TOTAL) fprintf(stderr, "workspace too small: %zu < %zu\n", ws_size, (size_t)WS_TOTAL);
  Params p{};
  const float** pp = (const float**)&p;
  for (int i = 0; i < 29; ++i) pp[i] = (const float*)d_in[i];
  p.out = (float*)d_out;
  p.ws = (char*)d_ws;
  hipMemsetAsync(d_ws, 0, 16384, stream);
  void* args[] = {&p};
  hipError_t e = hipLaunchCooperativeKernel((void*)hybrid_megakernel, dim3(grid_blocks), dim3(256), args, 0, stream);
  if (e != hipSuccess) fprintf(stderr, "cooperative launch failed: %s (grid %d)\n", hipGetErrorString(e), grid_blocks);
}
```

```cpp
#include <hip/hip_runtime.h>
#include <hip/hip_cooperative_groups.h>
#include <cstdio>
namespace cg = cooperative_groups;

typedef unsigned short u16;
typedef __attribute__((ext_vector_type(8))) short bf16x8;
typedef __attribute__((ext_vector_type(4))) short s16x4;
typedef __attribute__((ext_vector_type(4))) float f32x4;
#define DI __device__ __forceinline__
#define MFMA(a, b, c) __builtin_amdgcn_mfma_f32_16x16x32_bf16((a), (b), (c), 0, 0, 0)

constexpr int NPT = 8192;
constexpr int GT = 12288;
constexpr int NGROUP = 2;
constexpr int PW = 2176;
constexpr int NCH = GT / 64;
constexpr float EPS = 1e-6f;
constexpr float LOG2E = 1.4426950408889634f;

constexpr int PC_RQ = 0, PC_RK = 256, PC_RG = 512, PC_WQ = 768, PC_WK = 1024, PC_DQ = 1152, PC_DK = 1408, PC_HQ = 1664, PC_HG = 1920;
constexpr int VH_RET = 0, VH_WIN = 4, VH_DIFF = 6, VH_HGRN = 10;

constexpr size_t OFF_KN = 14336;
constexpr size_t OFF_MOD = 16384;
constexpr size_t OFF_ROPEA = OFF_MOD + 2 * 5 * 6144 * 4;
constexpr size_t OFF_ROPEB = OFF_ROPEA + 64 * 16 * 8;
constexpr size_t OFF_WIN = OFF_ROPEB + 64 * 8 * 8;
constexpr size_t OFF_WOUT = OFF_WIN + (size_t)2 * 3584 * 1024 * 2;
constexpr size_t OFF_WFI = OFF_WOUT + (size_t)2 * 1024 * 1024 * 2;
constexpr size_t OFF_WFO = OFF_WFI + (size_t)2 * 5632 * 1024 * 2;
constexpr size_t OFF_CWK = OFF_WFO + (size_t)2 * 1024 * 2816 * 2;
constexpr size_t OFF_CWVT = OFF_CWK + (size_t)2 * 4 * 2 * 512 * 64 * 2;
constexpr size_t OFF_CDK = OFF_CWVT + (size_t)2 * 4 * 2 * 512 * 64 * 2;
constexpr size_t OFF_CDVT = OFF_CDK + (size_t)2 * 4 * 4 * 2 * 512 * 32 * 2;
constexpr size_t OFF_HB = OFF_CDVT + (size_t)2 * 4 * 4 * 64 * 512 * 2;
constexpr size_t OFF_PB = OFF_HB + (size_t)GT * 1024 * 2;
constexpr size_t OFF_VT = OFF_PB + (size_t)GT * 2816 * 2;
constexpr size_t OFF_LF = OFF_VT + (size_t)14 * 64 * GT * 2;
constexpr size_t OFF_ST = OFF_LF + (size_t)2 * GT * 256 * 4;
constexpr size_t OFF_DEC = OFF_ST + (size_t)2 * NCH * 2 * 4 * 4096 * 4;
constexpr size_t WS_TOTAL = OFF_DEC + (size_t)2 * NCH * 2 * 4 * 64 * 4;

constexpr size_t O_SRET = 25165824, O_CWK = 27262976, O_CWV = 29360128, O_CDK = 31457280, O_CDV = 35651584, O_SHG = 39845888;

struct Params {
  const float *x_prompt, *x_sample, *state_ret, *cwk, *cwv, *cdk, *cdv, *state_hgrn, *c, *c_ctx, *norm1_g, *norm2_g, *w_ada, *b_ada,
      *w_in, *ret_decay, *ret_norm_g, *win_q_norm, *win_k_norm, *win_sink, *diff_q_norm, *diff_k_norm, *diff_lambda, *diff_norm_g,
      *hgrn_lb, *hgrn_norm_g, *w_out, *w_ffn_in, *w_ffn_out;
  float* out;
  char* ws;
};

typedef float f32x2_t __attribute__((ext_vector_type(2)));
typedef __bf16 bf16x2_t __attribute__((ext_vector_type(2)));
DI unsigned pack2(float a, float b) { f32x2_t v = {a, b}; bf16x2_t r = __builtin_convertvector(v, bf16x2_t); return __builtin_bit_cast(unsigned, r); }
DI u16 f2bf(float x) { return (u16)(pack2(x, 0.f) & 0xffffu); }
DI float bf2f(u16 h) { return __uint_as_float(((unsigned)h) << 16); }
DI float silu(float x) { return x * __builtin_amdgcn_rcpf(1.f + __builtin_amdgcn_exp2f(-1.4426950408889634f * x)); }
DI int get_tid() { int t = threadIdx.x & 255; asm volatile("" : "+v"(t)); return t; }
DI int get_vb() { int t = __builtin_amdgcn_readfirstlane((int)(blockIdx.x * 2 + (threadIdx.x >> 8))); asm volatile("" : "+s"(t)); return t; }
#define NVB ((int)gridDim.x * 2)
DI int cond_of(int gtok) { return gtok < NPT ? 0 : 1 + ((gtok - NPT) >> 12); }

template <class RM>
DI void transpose_tile(const float* __restrict__ src, size_t ld_src, u16* __restrict__ dst, size_t ld_dst, float* sm, RM rowmap) {
  const int tid = get_tid();
#pragma unroll
  for (int i = 0; i < 16; ++i) { int e = tid + 256 * i; int r = e >> 6, c = e & 63; sm[r * 65 + c] = src[(size_t)r * ld_src + c]; }
  __syncthreads();
#pragma unroll
  for (int i = 0; i < 16; ++i) { int e = tid + 256 * i; int c = e >> 6, r = e & 63; dst[(size_t)rowmap(c) * ld_dst + r] = f2bf(sm[r * 65 + c]); }
  __syncthreads();
}

struct WItem { const float* src; size_t ld_src; u16* dst; size_t ld_dst; int kind, nb; };
DI WItem weight_desc(const Params& P, int l, int r) {
  WItem w;
  if (r < 896) { const int kt = r / 56, nt = r % 56; w.src = P.w_in + (size_t)l * 1024 * 3584 + (size_t)kt * 64 * 3584 + nt * 64; w.ld_src = 3584;
                 w.dst = (u16*)(P.ws + OFF_WIN) + (size_t)l * 3584 * 1024 + kt * 64; w.ld_dst = 1024; w.kind = 1; w.nb = nt * 64; }
  else if (r < 1152) { r -= 896; const int kt = r / 16, nt = r % 16; w.src = P.w_out + (size_t)l * 1024 * 1024 + (size_t)kt * 64 * 1024 + nt * 64; w.ld_src = 1024;
                 w.dst = (u16*)(P.ws + OFF_WOUT) + (size_t)l * 1024 * 1024 + kt * 64; w.ld_dst = 1024; w.kind = 0; w.nb = nt * 64; }
  else if (r < 2560) { r -= 1152; const int kt = r / 88, nt = r % 88; w.src = P.w_ffn_in + (size_t)l * 1024 * 5632 + (size_t)kt * 64 * 5632 + nt * 64; w.ld_src = 5632;
                 w.dst = (u16*)(P.ws + OFF_WFI) + (size_t)l * 5632 * 1024 + kt * 64; w.ld_dst = 1024; w.kind = 2; w.nb = nt * 64; }
  else { r -= 2560; const int kt = r / 16, nt = r % 16; w.src = P.w_ffn_out + (size_t)l * 2816 * 1024 + (size_t)kt * 64 * 1024 + nt * 64; w.ld_src = 1024;
                 w.dst = (u16*)(P.ws + OFF_WFO) + (size_t)l * 1024 * 2816 + kt * 64; w.ld_dst = 2816; w.kind = 0; w.nb = nt * 64; }
  return w;
}
DI int weight_rowmap(int kind, int nb, int c) {
  const int cc = nb + c;
  if (kind == 1) { const int ct = cc & 255; return (cc & ~255) + 128 * ((ct >> 5) & 1) + 32 * (ct >> 6) + (ct & 31); }
  if (kind == 2) { const int sgn = cc >= 2816 ? 1 : 0; const int jn = cc - sgn * 2816; return 256 * (jn >> 7) + 128 * sgn + (jn & 127); }
  return cc;
}
DI void transpose2(const WItem& a, const WItem& b, const bool has_b, float* sm) {
  const int tid = get_tid();
  float va[16], vb[16];
#pragma unroll
  for (int i = 0; i < 16; ++i) { const int e = tid + 256 * i; const int r = e >> 6, c = e & 63; va[i] = __builtin_nontemporal_load(a.src + (size_t)r * a.ld_src + c); }
  if (has_b) {
#pragma unroll
    for (int i = 0; i < 16; ++i) { const int e = tid + 256 * i; const int r = e >> 6, c = e & 63; vb[i] = __builtin_nontemporal_load(b.src + (size_t)r * b.ld_src + c); }
  } else {
#pragma unroll
    for (int i = 0; i < 16; ++i) vb[i] = 0.f;
  }
#pragma unroll
  for (int i = 0; i < 16; ++i) { const int e = tid + 256 * i; const int r = e >> 6, c = e & 63; sm[r * 65 + c] = va[i]; sm[4160 + r * 65 + c] = vb[i]; }
  __syncthreads();
#pragma unroll
  for (int i = 0; i < 16; ++i) { const int e = tid + 256 * i; const int c = e >> 6, r = e & 63; a.dst[(size_t)weight_rowmap(a.kind, a.nb, c) * a.ld_dst + r] = f2bf(sm[r * 65 + c]); }
  if (has_b) {
#pragma unroll
    for (int i = 0; i < 16; ++i) { const int e = tid + 256 * i; const int c = e >> 6, r = e & 63; b.dst[(size_t)weight_rowmap(b.kind, b.nb, c) * b.ld_dst + r] = f2bf(sm[4160 + r * 65 + c]); }
  }
  __syncthreads();
}

DI void prep_l1_half(const Params& P, char* smem, int part) {
  constexpr int PER_L = 896 + 256 + 1408 + 704, HALFN = PER_L / 2, NUNITS = (GT / 256) * 4;
  if ((int)gridDim.x <= NUNITS || (int)blockIdx.x < NUNITS) return;
  const int vb0 = get_vb() - NUNITS * 2, nvb = NVB - NUNITS * 2;
  const int rend = (part + 1) * HALFN;
  for (int r = part * HALFN + vb0; r < rend; r += 2 * nvb) {
    const int r2 = r + nvb; const bool has_b = r2 < rend;
    const WItem wa = weight_desc(P, 1, r);
    const WItem wb = weight_desc(P, 1, has_b ? r2 : r);
    transpose2(wa, wb, has_b, (float*)smem);
  }
}

DI void prep_phase(const Params& P, char* smem) {
  float* sm = (float*)smem;
  const int tid = get_tid();
  constexpr int PER_L = 896 + 256 + 1408 + 704;
  constexpr int N_W = 2 * PER_L;
  constexpr int N_CWV = 128, N_CDV = 256, N_MOD = 192;
  constexpr int N_KN = 80;
  constexpr int TOTAL = N_W + N_CWV + N_CDV + N_MOD + N_KN + 1;
  const int n_w_now = ((int)gridDim.x > (GT / 256) * 4) ? PER_L : N_W;
  for (int it = get_vb(); it < n_w_now; it += 2 * NVB) {
    const int it2 = it + NVB; const bool has_b = it2 < n_w_now;
    const WItem wa = weight_desc(P, it / PER_L, it % PER_L);
    const WItem wb = weight_desc(P, has_b ? it2 / PER_L : it / PER_L, has_b ? it2 % PER_L : it % PER_L);
    transpose2(wa, wb, has_b, sm);
  }
  for (int it = N_W + (get_vb() + NVB - (320 % NVB)) % NVB; it < TOTAL; it += NVB) {
    if (it < N_W) {
      int l = it / PER_L, r = it % PER_L;
      if (r < 896) {
        int kt = r / 56, nt = r % 56;
        const float* src = P.w_in + (size_t)l * 1024 * 3584 + (size_t)kt * 64 * 3584 + nt * 64;
        u16* dst = (u16*)(P.ws + OFF_WIN) + (size_t)l * 3584 * 1024 + kt * 64;
        int nb = nt * 64;
        transpose_tile(src, 3584, dst, 1024, sm, [nb](int c) { int cc = nb + c; int ct = cc & 255; return (cc & ~255) + 128 * ((ct >> 5) & 1) + 32 * (ct >> 6) + (ct & 31); });
      } else if (r < 1152) {
        r -= 896; int kt = r / 16, nt = r % 16;
        const float* src = P.w_out + (size_t)l * 1024 * 1024 + (size_t)kt * 64 * 1024 + nt * 64;
        u16* dst = (u16*)(P.ws + OFF_WOUT) + (size_t)l * 1024 * 1024 + kt * 64;
        int nb = nt * 64;
        transpose_tile(src, 1024, dst, 1024, sm, [nb](int c) { return nb + c; });
      } else if (r < 2560) {
        r -= 1152; int kt = r / 88, nt = r % 88;
        const float* src = P.w_ffn_in + (size_t)l * 1024 * 5632 + (size_t)kt * 64 * 5632 + nt * 64;
        u16* dst = (u16*)(P.ws + OFF_WFI) + (size_t)l * 5632 * 1024 + kt * 64;
        int nb = nt * 64;
        transpose_tile(src, 5632, dst, 1024, sm, [nb](int c) { int n = nb + c; int s = n >= 2816 ? 1 : 0; int jn = n - s * 2816; return 256 * (jn >> 7) + 128 * s + (jn & 127); });
      } else {
        r -= 2560; int kt = r / 16, nt = r % 16;
        const float* src = P.w_ffn_out + (size_t)l * 2816 * 1024 + (size_t)kt * 64 * 1024 + nt * 64;
        u16* dst = (u16*)(P.ws + OFF_WFO) + (size_t)l * 1024 * 2816 + kt * 64;
        int nb = nt * 64;
        transpose_tile(src, 1024, dst, 2816, sm, [nb](int c) { return nb + c; });
      }
    } else if (it < N_W + N_CWV) {
      int r = it - N_W; int mat = r >> 3, kt = r & 7;
      const float* src = P.cwv + (size_t)mat * 512 * 64 + (size_t)kt * 64 * 64;
      const int dm = (((mat >> 1) & 1) * 4 + (mat >> 2)) * 2 + (mat & 1);
      u16* dst = (u16*)(P.ws + OFF_CWVT) + (size_t)dm * 64 * 512 + kt * 64;
      transpose_tile(src, 64, dst, 512, sm, [](int c) { return c; });
    } else if (it < N_W + N_CWV + N_CDV) {
      int r = it - N_W - N_CWV; int mat = r >> 3, kt = r & 7;
      const float* src = P.cdv + (size_t)mat * 512 * 64 + (size_t)kt * 64 * 64;
      const int dm = (((mat >> 2) & 1) * 4 + (mat >> 3)) * 4 + (mat & 3);
      u16* dst = (u16*)(P.ws + OFF_CDVT) + (size_t)dm * 64 * 512 + kt * 64;
      transpose_tile(src, 64, dst, 512, sm, [](int c) { return c; });
    } else if (it < N_W + N_CWV + N_CDV + N_MOD) {
      int r = it - N_W - N_CWV - N_CDV; int l = r / 96, cb = r % 96;
      for (int e = tid; e < 5 * 1024; e += 256) { int j = e >> 10, k = e & 1023; float v = (j == 0) ? P.c_ctx[k] : P.c[(j - 1) * 1024 + k]; sm[e] = silu(v); }
      __syncthreads();
      const int w = tid >> 6, lane = tid & 63; const int col = cb * 64 + lane;
      float acc[5] = {0.f, 0.f, 0.f, 0.f, 0.f};
      const float* wp = P.w_ada + (size_t)l * 1024 * 6144 + col;
#pragma unroll 8
      for (int k = w * 256; k < w * 256 + 256; ++k) {
        float wv = wp[(size_t)k * 6144];
#pragma unroll
        for (int j = 0; j < 5; ++j) acc[j] += sm[j * 1024 + k] * wv;
      }
      float* red = sm + 5 * 1024;
#pragma unroll
      for (int j = 0; j < 5; ++j) red[(w * 5 + j) * 64 + lane] = acc[j];
      __syncthreads();
      if (w == 0) {
        float* mod = (float*)(P.ws + OFF_MOD);
#pragma unroll
        for (int j = 0; j < 5; ++j) {
          float s = red[(0 * 5 + j) * 64 + lane] + red[(1 * 5 + j) * 64 + lane] + red[(2 * 5 + j) * 64 + lane] + red[(3 * 5 + j) * 64 + lane];
          mod[(size_t)(l * 5 + j) * 6144 + col] = s + P.b_ada[l * 6144 + col];
        }
      }
      __syncthreads();
    } else if (it < N_W + N_CWV + N_CDV + N_MOD + N_KN) {
      const int mi = it - (N_W + N_CWV + N_CDV + N_MOD);
      const float* src; int dim;
      if (mi < 16) { const int l_ = mi >> 3, b_ = (mi >> 1) & 3, kv = mi & 1; src = P.cwk + (size_t)((b_ * 2 + l_) * 2 + kv) * 512 * 64; dim = 64; }
      else { const int d_ = mi - 16; const int l_ = d_ >> 5, b_ = (d_ >> 3) & 3, h_ = (d_ >> 1) & 3, c_ = d_ & 1; src = P.cdk + (size_t)(((b_ * 2 + l_) * 4 + h_) * 2 + c_) * 512 * 32; dim = 32; }
      float mxn = 0.f;
      for (int k = tid; k < 512; k += 256) {
        float ss = 0.f;
        for (int i = 0; i < dim; i += 4) { const float4 v = *(const float4*)(src + (size_t)k * dim + i); ss += v.x * v.x + v.y * v.y + v.z * v.z + v.w * v.w; }
        mxn = fmaxf(mxn, ss);
      }
#pragma unroll
      for (int o_ = 32; o_ >= 1; o_ >>= 1) mxn = fmaxf(mxn, __shfl_xor(mxn, o_));
      if ((tid & 63) == 0) sm[tid >> 6] = mxn;
      __syncthreads();
      if (tid == 0) ((float*)(P.ws + OFF_KN))[mi] = fmaxf(fmaxf(sm[0], sm[1]), fmaxf(sm[2], sm[3]));
      __syncthreads();
    } else {
      float2* ta = (float2*)(P.ws + OFF_ROPEA); float2* tb = (float2*)(P.ws + OFF_ROPEB);
      for (int e = tid; e < 64 * 16 + 64 * 8; e += 256) {
        int pos, i, half;
        if (e < 1024) { pos = e >> 4; i = e & 15; half = 16; } else { int e2 = e - 1024; pos = e2 >> 3; i = e2 & 7; half = 8; }
        const double r16 = 0.5623413251903491;
        double inv = 1.0; int n = (half == 16) ? i : 2 * i;
        for (int q = 0; q < n; ++q) inv *= r16;
        float angf = (float)pos * (float)inv;
        double ang = (double)angf;
        double nq = rint(ang * 0.6366197723675814);
        double rr = ang - nq * 1.5707963267948966;
        double r2 = rr * rr;
        double sn = rr * (1.0 - r2 / 6.0 * (1.0 - r2 / 20.0 * (1.0 - r2 / 42.0 * (1.0 - r2 / 72.0 * (1.0 - r2 / 110.0 * (1.0 - r2 / 156.0))))));
        double cs = 1.0 - r2 / 2.0 * (1.0 - r2 / 12.0 * (1.0 - r2 / 30.0 * (1.0 - r2 / 56.0 * (1.0 - r2 / 90.0 * (1.0 - r2 / 132.0 * (1.0 - r2 / 182.0))))));
        int qd = ((int)nq) & 3;
        double c_, s_;
        if (qd == 0) { c_ = cs; s_ = sn; } else if (qd == 1) { c_ = -sn; s_ = cs; } else if (qd == 2) { c_ = -cs; s_ = -sn; } else { c_ = sn; s_ = -cs; }
        float2 v = make_float2((float)c_, (float)s_);
        if (e < 1024) ta[e] = v; else tb[e - 1024] = v;
      }
    }
  }
  {
    u16* d1 = (u16*)(P.ws + OFF_CWK);
    for (size_t e = (size_t)get_vb() * 256 + tid; e < (size_t)2 * 4 * 2 * 512 * 64; e += (size_t)NVB * 256) {
      size_t inner = e & (size_t)(2 * 512 * 64 - 1); size_t lb = e / (2 * 512 * 64); int l = (int)(lb >> 2), b = (int)(lb & 3);
      d1[e] = f2bf(P.cwk[((size_t)(b * 2 + l)) * (2 * 512 * 64) + inner]);
    }
    u16* d2 = (u16*)(P.ws + OFF_CDK);
    for (size_t e = (size_t)get_vb() * 256 + tid; e < (size_t)2 * 4 * 4 * 2 * 512 * 32; e += (size_t)NVB * 256) {
      size_t inner = e & (size_t)(4 * 2 * 512 * 32 - 1); size_t lb = e / (4 * 2 * 512 * 32); int l = (int)(lb >> 2), b = (int)(lb & 3);
      d2[e] = f2bf(P.cdk[((size_t)(b * 2 + l)) * (4 * 2 * 512 * 32) + inner]);
    }
  }
}

DI void norm_phase(const Params& P, int l, int g, int which, const bool idle_only) {
  const int tid_ = get_tid(); const int lane = tid_ & 63, w = tid_ >> 6;
  const float* mod = (const float*)(P.ws + OFF_MOD);
  u16* HB = (u16*)(P.ws + OFF_HB);
  const float* gn = (which ? P.norm2_g : P.norm1_g) + l * 1024;
  int vb0 = get_vb(), nvb = NVB;
  if (idle_only) { const int nunits = (GT / 256) * 4; if ((int)gridDim.x > nunits) { if ((int)blockIdx.x < nunits) return; vb0 -= nunits * 2; nvb -= nunits * 2; } }
  const int rows_per = (GT + nvb - 1) / nvb;
  const int rbeg = vb0 * rows_per, rend = (rbeg + rows_per < GT) ? rbeg + rows_per : GT;
  float4 gg[4], s4[4], h4[4];
#pragma unroll
  for (int i = 0; i < 4; ++i) { gg[i] = *(const float4*)(gn + (i * 64 + lane) * 4); s4[i] = gg[i]; h4[i] = gg[i]; }
  int cur_cond = -1;
  auto row_src = [&](int row) -> const float* {
    const int gtok = g * GT + row;
    if (which == 0 && l == 0) return gtok < NPT ? P.x_prompt + (size_t)gtok * 1024 : P.x_sample + (size_t)(gtok - NPT) * 1024;
    return P.out + (size_t)gtok * 1024;
  };
  int row = rbeg + w;
  float4 v[4];
  if (row < rend) {
    const float* src = row_src(row);
#pragma unroll
    for (int i = 0; i < 4; ++i) v[i] = *(const float4*)(src + (i * 64 + lane) * 4);
  }
  for (; row < rend; row += 4) {
    const int gtok = g * GT + row;
    float ss = 0.f;
#pragma unroll
    for (int i = 0; i < 4; ++i) ss += v[i].x * v[i].x + v[i].y * v[i].y + v[i].z * v[i].z + v[i].w * v[i].w;
    float4 vn[4];
    if (row + 4 < rend) {
      const float* srcn = row_src(row + 4);
#pragma unroll
      for (int i = 0; i < 4; ++i) vn[i] = *(const float4*)(srcn + (i * 64 + lane) * 4);
    } else {
#pragma unroll
      for (int i = 0; i < 4; ++i) vn[i] = v[i];
    }
    const int cnd = cond_of(gtok);
    if (cnd != cur_cond) {
      cur_cond = cnd;
      const float* mrow = mod + (size_t)(l * 5 + cnd) * 6144;
      const float* sh = mrow + (which ? 3 : 0) * 1024; const float* sc = mrow + (which ? 4 : 1) * 1024;
#pragma unroll
      for (int i = 0; i < 4; ++i) { s4[i] = *(const float4*)(sc + (i * 64 + lane) * 4); h4[i] = *(const float4*)(sh + (i * 64 + lane) * 4); }
    }
#pragma unroll
    for (int o = 32; o >= 1; o >>= 1) ss += __shfl_xor(ss, o);
    const float rstd = rsqrtf(ss * (1.f / 1024.f) + EPS);
#pragma unroll
    for (int i = 0; i < 4; ++i) {
      const int col = (i * 64 + lane) * 4;
      const float a = v[i].x * rstd * gg[i].x * (1.f + s4[i].x) + h4[i].x, b = v[i].y * rstd * gg[i].y * (1.f + s4[i].y) + h4[i].y;
      const float c = v[i].z * rstd * gg[i].z * (1.f + s4[i].z) + h4[i].z, d = v[i].w * rstd * gg[i].w * (1.f + s4[i].w) + h4[i].w;
      uint2 o2; o2.x = pack2(a, b); o2.y = pack2(c, d);
      *(uint2*)(HB + (size_t)row * 1024 + col) = o2;
    }
#pragma unroll
    for (int i = 0; i < 4; ++i) v[i] = vn[i];
  }
}

namespace pg8 {
#define PG8_LAS __attribute__((address_space(3)))
typedef unsigned short bf16_t;
typedef short bf16x8 __attribute__((ext_vector_type(8)));
typedef float f32x4 __attribute__((ext_vector_type(4)));
typedef unsigned u32x4 __attribute__((ext_vector_type(4)));
typedef PG8_LAS unsigned char PG8_LAS_T;
constexpr int BM = 256, BK = 64, HALF = 128, HTB = HALF * BK * 2  , STAGE_BYTES = 8 * HTB, NXCD = 8, WGM = 6;

__host__ __device__ __forceinline__ int lds_byte(int r, int c) { const int st = (r >> 4) * 2 + (c >> 5), rr = r & 15, cc = c & 31, ob = rr * 64 + cc * 2; return st * 1024 + (ob ^ (((ob >> 9) & 1) << 5)); }
__host__ __device__ __forceinline__ void stage_rc(int b, int& R, int& C) { const int st = b / 1024, sb = b % 1024, swz = sb ^ (((sb >> 9) & 1) << 5); R = (st >> 1) * 16 + swz / 64; C = (st & 1) * 32 + (swz % 64) / 2; }
__host__ __device__ __forceinline__ int perm32(int rho) { const int n = rho >> 4, i = rho & 15; return 8 * (i >> 2) + 4 * n + (i & 3); }

struct Unit { int pm, pn; };
struct Gemm { const bf16_t* A; const bf16_t* Bt; int M, N, K; };

struct StaticOrder {
    int nM, nN, nwg, G, c;
    __host__ __device__ void init(int M, int N, int G_, int c_) { nM = M / BM; nN = N / BM; nwg = nM * nN; G = G_; c = c_; }
    __host__ __device__ bool next(int i, Unit& u) const {
        const long L = (long)i * G + c; if (L >= nwg) return false;
        int wgid = (int)L; { const int q = nwg / NXCD, r = nwg % NXCD, xcd = wgid % NXCD, off = wgid / NXCD; wgid = (xcd < r ? xcd * (q + 1) : r * (q + 1) + (xcd - r) * q) + off; }
        const int nig = WGM * nN, gid = wgid / nig, fm = gid * WGM, gsz = (nM - fm) < WGM ? (nM - fm) : WGM;
        u.pm = fm + ((wgid % nig) % gsz); u.pn = (wgid % nig) / gsz; return true;
    }
    __device__ __forceinline__ void a_ready(const Unit&) const {}
    __device__ __forceinline__ void done(const Unit&) const {}
};

template <class Epi, class Sched, bool STAMP = false>
__device__ __forceinline__ void gemm_phase(PG8_LAS unsigned char* lds, const Gemm g, const Sched& S, const Epi& E, unsigned long long* stamps) {
    int tid_l = threadIdx.x; asm volatile("" : "+v"(tid_l));
    const int tid = tid_l, wid = __builtin_amdgcn_readfirstlane(tid >> 6), lane = tid & 63, wr = wid >> 2, wc = wid & 3, fr = lane & 15, fq = lane >> 4;
    const int K = g.K, nt = K / BK;
    int ts_lo = 0, ts_hi = 0, nts = 0; const unsigned long long rt_entry = STAMP ? (unsigned long long)wall_clock64() : 0ull;
#define PG8_STAMP() do { if (STAMP && wid == 0 && nts < 64) { const unsigned long long _c = (unsigned long long)clock64(); \
        ts_lo = (lane == nts) ? (int)(unsigned)_c : ts_lo; ts_hi = (lane == nts) ? (int)(unsigned)(_c >> 32) : ts_hi; ++nts; } } while (0)
    PG8_STAMP();
    unsigned voffA[2], voffB[2];
#pragma unroll
    for (int i = 0; i < 2; ++i) { int R, C; stage_rc(tid * 16 + i * 8192, R, C); const int Rb = Epi::PERM ? ((R & ~31) + perm32(R & 31)) : R;
        voffA[i] = (unsigned)(R * K + C) * 2u; voffB[i] = (unsigned)(Rb * K + C) * 2u; }
    const size_t kstep = (size_t)(BK * 2);
    const size_t hstep = (size_t)HALF * K * 2;
    const size_t tstep = 2 * hstep;
    const unsigned ldsw = (unsigned)wid * 1024u;
    const int aoff = lds_byte(wr * 64 + fr, fq * 8), boff = lds_byte(wc * 32 + fr, fq * 8);
#define PG8_SA(b, h) (((b) * 2 + (h)) * HTB)
#define PG8_SB(b, h) ((4 + (b) * 2 + (h)) * HTB)
#define PG8_STAGE(bufoff, gbase, voff) do { _Pragma("unroll") for (int _i = 0; _i < 2; ++_i) \
        __builtin_amdgcn_global_load_lds((const unsigned*)((const char*)(gbase) + (voff)[_i]), (PG8_LAS unsigned*)(lds + (bufoff) + ldsw + _i * 8192), 16, 0, 0); } while (0)
#define PG8_LDA(dst, b, h) do { _Pragma("unroll") for (int m = 0; m < 4; ++m) _Pragma("unroll") for (int k = 0; k < 2; ++k) dst[m][k] = *(const PG8_LAS bf16x8*)(lds + PG8_SA(b, h) + aoff + m * 2048 + k * 1024); } while (0)
#define PG8_LDB(dst, b, h) do { _Pragma("unroll") for (int n = 0; n < 2; ++n) _Pragma("unroll") for (int k = 0; k < 2; ++k) dst[n][k] = *(const PG8_LAS bf16x8*)(lds + PG8_SB(b, h) + boff + n * 2048 + k * 1024); } while (0)
#define PG8_MMA(ai, bj, At, Bt) do { __builtin_amdgcn_s_setprio(1); _Pragma("unroll") for (int m = 0; m < 4; ++m) _Pragma("unroll") for (int n = 0; n < 2; ++n) _Pragma("unroll") for (int k = 0; k < 2; ++k) \
        acc[ai][bj][m][n] = __builtin_amdgcn_mfma_f32_16x16x32_bf16(Bt[n][k], At[m][k], acc[ai][bj][m][n], 0, 0, 0); __builtin_amdgcn_s_setprio(0); } while (0)
#define PG8_WAIT_V(n) asm volatile("s_waitcnt vmcnt(" #n ")" ::: "memory")
#define PG8_WAIT_L(n) asm volatile("s_waitcnt lgkmcnt(" #n ")" ::: "memory")
#define PG8_BAR __builtin_amdgcn_s_barrier()
#define PG8_SCHED __builtin_amdgcn_sched_barrier(0)
    Unit cur, nxt; int ui = 0;
    if (!S.next(0, cur)) return;
    f32x4 acc[2][2][4][2];
#pragma unroll
    for (int a = 0; a < 2; ++a)
#pragma unroll
        for (int b = 0; b < 2; ++b)
#pragma unroll
            for (int m = 0; m < 4; ++m)
#pragma unroll
                for (int n = 0; n < 2; ++n) acc[a][b][m][n] = (f32x4){0.f, 0.f, 0.f, 0.f};
    bf16x8 At[4][2], B0[2][2], B1[2][2];
    const char* cA = (const char*)g.A + (size_t)cur.pm * tstep; const char* cB = (const char*)g.Bt + (size_t)cur.pn * tstep;
    S.a_ready(cur);
    PG8_STAGE(PG8_SB(0, 0), cB, voffB); PG8_STAGE(PG8_SA(0, 0), cA, voffA); PG8_STAGE(PG8_SB(0, 1), cB + hstep, voffB); PG8_STAGE(PG8_SA(0, 1), cA + hstep, voffA);
    if (wr == 1) PG8_BAR;
    PG8_WAIT_V(4); PG8_BAR;
    PG8_STAGE(PG8_SB(1, 0), cB + kstep, voffB); PG8_STAGE(PG8_SA(1, 0), cA + kstep, voffA); PG8_STAGE(PG8_SB(1, 1), cB + hstep + kstep, voffB);
    PG8_WAIT_V(6); PG8_BAR;
    PG8_STAMP();
    for (;;) {
        const bool has_next = S.next(ui + 1, nxt);
        const char* nA = has_next ? (const char*)g.A + (size_t)nxt.pm * tstep : cA; const char* nB = has_next ? (const char*)g.Bt + (size_t)nxt.pn * tstep : cB;
        for (int t = 0; t < nt; t += 2) {
            const bool last = (t == nt - 2);
            const char* a1 = cA + (size_t)(t + 1) * kstep;
            const char* a2 = last ? nA : cA + (size_t)(t + 2) * kstep; const char* b2 = last ? nB : cB + (size_t)(t + 2) * kstep;
            const char* a3 = a2 + kstep; const char* b3 = b2 + kstep;
            if (last && has_next) S.a_ready(nxt);
            PG8_LDB(B0, 0, 0); PG8_SCHED; PG8_LDA(At, 0, 0); PG8_STAGE(PG8_SA(1, 1), a1 + hstep, voffA);
            PG8_WAIT_L(8); PG8_BAR; PG8_WAIT_L(0); PG8_MMA(0, 0, At, B0); PG8_BAR; PG8_SCHED;
            PG8_LDB(B1, 0, 1); PG8_STAGE(PG8_SB(0, 0), b2, voffB);
            PG8_BAR; PG8_WAIT_L(0); PG8_MMA(0, 1, At, B1); PG8_BAR;
            PG8_LDA(At, 0, 1); PG8_STAGE(PG8_SA(0, 0), a2, voffA);
            PG8_BAR; PG8_WAIT_L(0); PG8_MMA(1, 0, At, B0); PG8_BAR; PG8_SCHED;
            PG8_STAGE(PG8_SB(0, 1), b2 + hstep, voffB);
            PG8_WAIT_V(6); PG8_BAR; PG8_MMA(1, 1, At, B1); PG8_BAR;
            PG8_LDB(B0, 1, 0); PG8_SCHED; PG8_LDA(At, 1, 0); PG8_STAGE(PG8_SA(0, 1), a2 + hstep, voffA);
            PG8_WAIT_L(8); PG8_BAR; PG8_WAIT_L(0); PG8_MMA(0, 0, At, B0); PG8_BAR; PG8_SCHED;
            PG8_LDB(B1, 1, 1); PG8_STAGE(PG8_SB(1, 0), b3, voffB);
            PG8_BAR; PG8_WAIT_L(0); PG8_MMA(0, 1, At, B1); PG8_BAR;
            PG8_LDA(At, 1, 1); PG8_STAGE(PG8_SA(1, 0), a3, voffA);
            PG8_BAR; PG8_WAIT_L(0); PG8_MMA(1, 0, At, B0); PG8_BAR; PG8_SCHED;
            PG8_STAGE(PG8_SB(1, 1), b3 + hstep, voffB);
            PG8_WAIT_V(6); PG8_BAR; PG8_MMA(1, 1, At, B1); PG8_BAR;
        }
        PG8_STAMP();
        if constexpr (!Epi::AFTER_DRAIN) { E(acc, cur, wr, wc, fr, fq); S.done(cur); }
        PG8_STAMP();
        if (!has_next) break;
#pragma unroll
        for (int a = 0; a < 2; ++a)
#pragma unroll
            for (int b = 0; b < 2; ++b)
#pragma unroll
                for (int m = 0; m < 4; ++m)
#pragma unroll
                    for (int n = 0; n < 2; ++n) acc[a][b][m][n] = (f32x4){0.f, 0.f, 0.f, 0.f};
        cur = nxt; cA = nA; cB = nB; ++ui;
    }
    PG8_WAIT_V(0);
    if (wr == 0) PG8_BAR;
    PG8_BAR;
    if constexpr (Epi::AFTER_DRAIN) { E.fused(acc, cur, wr, wc, fr, fq, lds, wid, lane); S.done(cur); }
    PG8_STAMP();
    if (STAMP && wid == 0) { stamps[lane] = lane < nts ? (((unsigned long long)(unsigned)ts_hi << 32) | (unsigned)ts_lo) : 0ull;
        if (lane == 62) stamps[62] = rt_entry; if (lane == 63) stamps[63] = (unsigned long long)wall_clock64(); }
#undef PG8_STAMP
#undef PG8_SA
#undef PG8_SB
#undef PG8_STAGE
#undef PG8_LDA
#undef PG8_LDB
#undef PG8_MMA
#undef PG8_WAIT_V
#undef PG8_WAIT_L
#undef PG8_BAR
#undef PG8_SCHED
}
}


using pg8::Unit;
DI void st4bf(u16* p, float a, float b, float c, float d) { uint2 v; v.x = pack2(a, b); v.y = pack2(c, d); *(uint2*)p = v; }

template <int WHICH> struct EpiResid {
  static constexpr bool PERM = false, AFTER_DRAIN = false;
  const Params* P; int l, g;
  DI const float* xrow(int gtok) const {
    if (WHICH == 0 && l == 0) return gtok < NPT ? P->x_prompt + (size_t)gtok * 1024 : P->x_sample + (size_t)(gtok - NPT) * 1024;
    return P->out + (size_t)gtok * 1024;
  }
  template <int S> DI void loadx(f32x4 (&xv)[2][2], int gtok0, int wr, int fr, int col0) const {
    const float* xin = xrow(gtok0 + (S >> 2) * 128 + wr * 64 + (S & 3) * 16 + fr);
#pragma unroll
    for (int bj = 0; bj < 2; ++bj)
#pragma unroll
      for (int n = 0; n < 2; ++n) xv[bj][n] = *(const f32x4*)(xin + col0 + bj * 128 + n * 16);
  }
  template <int S> DI void storex(const f32x4 (&acc)[2][2][4][2], const f32x4 (&xv)[2][2], const f32x4 (&gv)[2][2], int gtok0, int wr, int fr, int col0) const {
    float* xo = P->out + (size_t)(gtok0 + (S >> 2) * 128 + wr * 64 + (S & 3) * 16 + fr) * 1024;
#pragma unroll
    for (int bj = 0; bj < 2; ++bj)
#pragma unroll
      for (int n = 0; n < 2; ++n) *(f32x4*)(xo + col0 + bj * 128 + n * 16) = xv[bj][n] + gv[bj][n] * acc[S >> 2][bj][S & 3][n];
  }
  DI void operator()(const f32x4 (&acc)[2][2][4][2], const Unit& u, int wr, int wc, int fr, int fq) const {
    const int gtok0 = g * GT + u.pm * 256;
    const float* gate = (const float*)(P->ws + OFF_MOD) + (size_t)(l * 5 + cond_of(gtok0)) * 6144 + (WHICH == 0 ? 2 : 5) * 1024;
    const int col0 = u.pn * 256 + wc * 32 + 4 * fq;
    f32x4 gv[2][2], xa[2][2], xb[2][2];
#pragma unroll
    for (int bj = 0; bj < 2; ++bj)
#pragma unroll
      for (int n = 0; n < 2; ++n) gv[bj][n] = *(const f32x4*)(gate + col0 + bj * 128 + n * 16);
    loadx<0>(xa, gtok0, wr, fr, col0);
    loadx<1>(xb, gtok0, wr, fr, col0); storex<0>(acc, xa, gv, gtok0, wr, fr, col0);
    loadx<2>(xa, gtok0, wr, fr, col0); storex<1>(acc, xb, gv, gtok0, wr, fr, col0);
    loadx<3>(xb, gtok0, wr, fr, col0); storex<2>(acc, xa, gv, gtok0, wr, fr, col0);
    loadx<4>(xa, gtok0, wr, fr, col0); storex<3>(acc, xb, gv, gtok0, wr, fr, col0);
    loadx<5>(xb, gtok0, wr, fr, col0); storex<4>(acc, xa, gv, gtok0, wr, fr, col0);
    loadx<6>(xa, gtok0, wr, fr, col0); storex<5>(acc, xb, gv, gtok0, wr, fr, col0);
    loadx<7>(xb, gtok0, wr, fr, col0); storex<6>(acc, xa, gv, gtok0, wr, fr, col0);
    storex<7>(acc, xb, gv, gtok0, wr, fr, col0);
  }
};

struct EpiSwiglu {
  static constexpr bool PERM = true, AFTER_DRAIN = false;
  const Params* P;
  DI void operator()(const f32x4 (&acc)[2][2][4][2], const Unit& u, int wr, int wc, int fr, int fq) const {
    u16* ACT = (u16*)(P->ws + OFF_PB);
#pragma unroll
    for (int ai = 0; ai < 2; ++ai)
#pragma unroll
      for (int m = 0; m < 4; ++m) {
        const int ltok = u.pm * 256 + ai * 128 + wr * 64 + m * 16 + fr;
        const f32x4 g0 = acc[ai][0][m][0], g1 = acc[ai][0][m][1], u0 = acc[ai][1][m][0], u1 = acc[ai][1][m][1];
        uint4 o4;
        o4.x = pack2(silu(g0[0]) * u0[0], silu(g0[1]) * u0[1]); o4.y = pack2(silu(g0[2]) * u0[2], silu(g0[3]) * u0[3]);
        o4.z = pack2(silu(g1[0]) * u1[0], silu(g1[1]) * u1[1]); o4.w = pack2(silu(g1[2]) * u1[2], silu(g1[3]) * u1[3]);
        *(uint4*)(ACT + (size_t)ltok * 2816 + u.pn * 128 + wc * 32 + 8 * fq) = o4;
      }
  }
};

struct EpiIn {
  static constexpr bool PERM = false, AFTER_DRAIN = false;
  const Params* P; int l, g;
  const __attribute__((address_space(3))) f32x2_t* ltab;
  DI void rope64(float (&x)[2][2][4], int ts, int fq) const {
    const __attribute__((address_space(3))) f32x2_t* ta = ltab;
#pragma unroll
    for (int bj = 0; bj < 2; ++bj) {
      const int pos = bj ? (ts & 63) : (ts >> 6);
#pragma unroll
      for (int j = 0; j < 4; ++j) { const f32x2_t cs = ta[pos * 16 + 4 * fq + j]; const float a = x[bj][0][j], b = x[bj][1][j]; x[bj][0][j] = a * cs.x - b * cs.y; x[bj][1][j] = b * cs.x + a * cs.y; }
    }
  }
  DI void rope32(float (&x)[2][2][4], int ts, int fq) const {
    const __attribute__((address_space(3))) f32x2_t* tb = ltab + 1024;
#pragma unroll
    for (int bj = 0; bj < 2; ++bj)
#pragma unroll
      for (int n = 0; n < 2; ++n) {
        const int pos = n ? (ts & 63) : (ts >> 6);
#pragma unroll
        for (int j = 0; j < 4; ++j) {
          const float v = x[bj][n][j]; const float p = __shfl_xor(v, 32);
          const f32x2_t cs = tb[pos * 8 + 4 * (fq & 1) + j];
          x[bj][n][j] = (fq < 2) ? (v * cs.x - p * cs.y) : (v * cs.x + p * cs.y);
        }
      }
  }
  DI void storeP(const float (&x)[2][2][4], int ltok, int pcol, int fq) const {
    u16* Pb = (u16*)(P->ws + OFF_PB) + (size_t)ltok * PW + pcol + 4 * fq;
#pragma unroll
    for (int bj = 0; bj < 2; ++bj)
#pragma unroll
      for (int n = 0; n < 2; ++n) st4bf(Pb + 32 * bj + 16 * n, x[bj][n][0], x[bj][n][1], x[bj][n][2], x[bj][n][3]);
  }
  DI void storeVT(const float (&x)[2][2][4], int ltok, int vhead, int fq) const {
    const int k = ltok & 3;
    u16* VT = (u16*)(P->ws + OFF_VT) + (size_t)(vhead * 64 + 4 * fq + k) * GT + (ltok & ~3);
#pragma unroll
    for (int bj = 0; bj < 2; ++bj)
#pragma unroll
      for (int n = 0; n < 2; ++n) {
        const float v0 = x[bj][n][0], v1 = x[bj][n][1], v2 = x[bj][n][2], v3 = x[bj][n][3];
        const float s01 = __shfl_xor((k & 1) ? v0 : v1, 1), s23 = __shfl_xor((k & 1) ? v2 : v3, 1);
        const float w0 = (k & 1) ? s01 : v0, w1 = (k & 1) ? v1 : s01, w2 = (k & 1) ? s23 : v2, w3 = (k & 1) ? v3 : s23;
        const float r0 = __shfl_xor((k & 2) ? w0 : w2, 2), r1 = __shfl_xor((k & 2) ? w1 : w3, 2);
        const float t0 = (k & 2) ? r0 : w0, t1 = (k & 2) ? r1 : w1, t2 = (k & 2) ? w2 : r0, t3 = (k & 2) ? w3 : r1;
        st4bf(VT + (size_t)(32 * bj + 16 * n) * GT, t0, t1, t2, t3);
      }
  }
  DI void storeF(const float (&x)[2][2][4], float* dst, int fq) const {
#pragma unroll
    for (int bj = 0; bj < 2; ++bj)
#pragma unroll
      for (int n = 0; n < 2; ++n) *(float4*)(dst + 32 * bj + 16 * n + 4 * fq) = make_float4(x[bj][n][0], x[bj][n][1], x[bj][n][2], x[bj][n][3]);
  }
  DI void operator()(const f32x4 (&acc)[2][2][4][2], const Unit& u, int wr, int wc, int fr, int fq) const {
    const int hc = u.pn * 256 + wc * 64;
    const int gtok0 = g * GT + u.pm * 256;
    const bool samp = gtok0 >= NPT;
    float lbv[2][2][4];
#pragma unroll
    for (int bj = 0; bj < 2; ++bj)
#pragma unroll
      for (int n = 0; n < 2; ++n)
#pragma unroll
        for (int j = 0; j < 4; ++j) lbv[bj][n][j] = 0.f;
    if (l == 1 && hc >= 2560 && hc < 3072) {
      const int dir = hc >= 2816 ? 1 : 0; const int c0 = hc - (dir ? 2816 : 2560);
#pragma unroll
      for (int bj = 0; bj < 2; ++bj)
#pragma unroll
        for (int n = 0; n < 2; ++n)
#pragma unroll
          for (int j = 0; j < 4; ++j) {
            const int ch = c0 + 32 * bj + 16 * n + 4 * fq + j;
            const float a0 = P->hgrn_lb[(0 * 2 + dir) * 256 + ch], a1 = P->hgrn_lb[(1 * 2 + dir) * 256 + ch];
            lbv[bj][n][j] = __builtin_amdgcn_rcpf(1.f + __expf(a1 - a0));
          }
    }
    slot<0, 0>(acc, u, wr, fr, fq, hc, samp, lbv); slot<0, 1>(acc, u, wr, fr, fq, hc, samp, lbv); slot<0, 2>(acc, u, wr, fr, fq, hc, samp, lbv); slot<0, 3>(acc, u, wr, fr, fq, hc, samp, lbv);
    slot<1, 0>(acc, u, wr, fr, fq, hc, samp, lbv); slot<1, 1>(acc, u, wr, fr, fq, hc, samp, lbv); slot<1, 2>(acc, u, wr, fr, fq, hc, samp, lbv); slot<1, 3>(acc, u, wr, fr, fq, hc, samp, lbv);
  }
  template <int ai, int m>
  DI void slot(const f32x4 (&acc)[2][2][4][2], const Unit& u, int wr, int fr, int fq, int hc, bool samp, const float (&lbv)[2][2][4]) const {
      {
        const int ltok = u.pm * 256 + ai * 128 + wr * 64 + m * 16 + fr;
        const int gtok = g * GT + ltok;
        const int ts = (gtok - NPT) & 4095, pb = gtok >> 8, pt = gtok & 255;
        float x[2][2][4];
#pragma unroll
        for (int bj = 0; bj < 2; ++bj)
#pragma unroll
          for (int n = 0; n < 2; ++n)
#pragma unroll
            for (int j = 0; j < 4; ++j) x[bj][n][j] = acc[ai][bj][m][n][j];
        if (hc < 256) {
          if (samp) rope64(x, ts, fq);
          storeP(x, ltok, PC_RQ + hc, fq);
        } else if (hc < 512) {
#pragma unroll
          for (int bj = 0; bj < 2; ++bj)
#pragma unroll
            for (int n = 0; n < 2; ++n)
#pragma unroll
              for (int j = 0; j < 4; ++j) x[bj][n][j] *= 0.125f;
          if (samp) rope64(x, ts, fq);
          storeP(x, ltok, PC_RK + hc - 256, fq);
        } else if (hc < 768) {
          storeVT(x, ltok, VH_RET + ((hc - 512) >> 6), fq);
        } else if (hc < 1024 || hc >= 3328) {
#pragma unroll
          for (int bj = 0; bj < 2; ++bj)
#pragma unroll
            for (int n = 0; n < 2; ++n)
#pragma unroll
              for (int j = 0; j < 4; ++j) x[bj][n][j] = silu(x[bj][n][j]);
          storeP(x, ltok, hc < 1024 ? PC_RG + hc - 768 : PC_HG + hc - 3328, fq);
        } else if (hc < 1408) {
          const bool isq = hc < 1280;
          float ss = 0.f;
#pragma unroll
          for (int bj = 0; bj < 2; ++bj)
#pragma unroll
            for (int n = 0; n < 2; ++n)
#pragma unroll
              for (int j = 0; j < 4; ++j) ss += x[bj][n][j] * x[bj][n][j];
          ss += __shfl_xor(ss, 16); ss += __shfl_xor(ss, 32);
          const float rstd = rsqrtf(ss * (1.f / 64.f) + EPS);
          const float* gn = (isq ? P->win_q_norm : P->win_k_norm) + l * 64 + 4 * fq;
#pragma unroll
          for (int bj = 0; bj < 2; ++bj)
#pragma unroll
            for (int n = 0; n < 2; ++n) { const float4 g4 = *(const float4*)(gn + 32 * bj + 16 * n); x[bj][n][0] *= rstd * g4.x; x[bj][n][1] *= rstd * g4.y; x[bj][n][2] *= rstd * g4.z; x[bj][n][3] *= rstd * g4.w; }
          if (isq) {
#pragma unroll
            for (int bj = 0; bj < 2; ++bj)
#pragma unroll
              for (int n = 0; n < 2; ++n)
#pragma unroll
                for (int j = 0; j < 4; ++j) x[bj][n][j] *= 0.125f * LOG2E;
            if (samp) rope64(x, ts, fq); storeP(x, ltok, PC_WQ + hc - 1024, fq); }
          else {
            const int kvh = (hc - 1280) >> 6;
            if (!samp) storeF(x, P->out + O_CWK + ((size_t)((pb * 2 + l) * 2 + kvh) * 256 + pt) * 64, fq);
            else rope64(x, ts, fq);
            storeP(x, ltok, PC_WK + hc - 1280, fq);
          }
        } else if (hc < 1536) {
          const int kvh = (hc - 1408) >> 6;
          if (!samp) storeF(x, P->out + O_CWV + ((size_t)((pb * 2 + l) * 2 + kvh) * 256 + pt) * 64, fq);
          storeVT(x, ltok, VH_WIN + kvh, fq);
        } else if (hc < 2048) {
          const bool isq = hc < 1792;
          const float* gn = (isq ? P->diff_q_norm : P->diff_k_norm) + l * 32 + 4 * fq;
#pragma unroll
          for (int bj = 0; bj < 2; ++bj) {
            float ss = 0.f;
#pragma unroll
            for (int n = 0; n < 2; ++n)
#pragma unroll
              for (int j = 0; j < 4; ++j) ss += x[bj][n][j] * x[bj][n][j];
            ss += __shfl_xor(ss, 16); ss += __shfl_xor(ss, 32);
            const float rstd = rsqrtf(ss * (1.f / 32.f) + EPS);
#pragma unroll
            for (int n = 0; n < 2; ++n) { const float4 g4 = *(const float4*)(gn + 16 * n); x[bj][n][0] *= rstd * g4.x; x[bj][n][1] *= rstd * g4.y; x[bj][n][2] *= rstd * g4.z; x[bj][n][3] *= rstd * g4.w; }
          }
          if (isq) {
#pragma unroll
            for (int bj = 0; bj < 2; ++bj)
#pragma unroll
              for (int n = 0; n < 2; ++n)
#pragma unroll
                for (int j = 0; j < 4; ++j) x[bj][n][j] *= 0.17677669529663687f * LOG2E;
            if (samp) rope32(x, ts, fq); storeP(x, ltok, PC_DQ + hc - 1536, fq); }
          else {
            const int h = (hc - 1792) >> 6;
            if (!samp) {
#pragma unroll
              for (int bj = 0; bj < 2; ++bj)
#pragma unroll
                for (int n = 0; n < 2; ++n)
                  *(float4*)(P->out + O_CDK + ((size_t)(((pb * 2 + l) * 4 + h) * 2 + bj) * 256 + pt) * 32 + 16 * n + 4 * fq) = make_float4(x[bj][n][0], x[bj][n][1], x[bj][n][2], x[bj][n][3]);
            } else rope32(x, ts, fq);
            storeP(x, ltok, PC_DK + hc - 1792, fq);
          }
        } else if (hc < 2304) {
          const int h = (hc - 2048) >> 6;
          if (!samp) storeF(x, P->out + O_CDV + ((size_t)((pb * 2 + l) * 4 + h) * 256 + pt) * 64, fq);
          storeVT(x, ltok, VH_DIFF + h, fq);
        } else if (hc < 2560) {
          storeP(x, ltok, PC_HQ + hc - 2304, fq);
        } else if (hc < 3072) {
          const int dir = hc >= 2816 ? 1 : 0; const int c0 = hc - (dir ? 2816 : 2560);
#pragma unroll
          for (int bj = 0; bj < 2; ++bj)
#pragma unroll
            for (int n = 0; n < 2; ++n)
#pragma unroll
              for (int j = 0; j < 4; ++j) {
                const float lb = lbv[bj][n][j];
                const float sg = __builtin_amdgcn_rcpf(1.f + __builtin_amdgcn_exp2f(-1.4426950408889634f * x[bj][n][j]));
                x[bj][n][j] = __logf(fmaxf(lb + (1.f - lb) * sg, 1e-30f));
              }
          storeF(x, (float*)(P->ws + OFF_LF) + ((size_t)dir * GT + ltok) * 256 + c0, fq);
        } else {
          storeVT(x, ltok, VH_HGRN + ((hc - 3072) >> 6), fq);
        }
      }
  }
};

template <class Epi>
DI void gemm_run(pg8::PG8_LAS_T* lds, const u16* A, const u16* Bt, int N, int K, const Epi& E) {
  pg8::Gemm gm; gm.A = A; gm.Bt = Bt; gm.M = GT; gm.N = N; gm.K = K;
  pg8::StaticOrder S; S.init(GT, N, (int)gridDim.x, (int)blockIdx.x);
  pg8::gemm_phase<Epi, pg8::StaticOrder, false>(lds, gm, S, E, nullptr);
}
DI float max3f(float a, float b, float c) { return fmaxf(fmaxf(a, b), c); }
template <int MODE>
DI void attn_compute(const char* kb, const char* vb, const bf16x8 (&qf)[2][2], f32x4 (&o)[4][2], const float mfix, f32x4 (&osum)[2],
                     const float scl, const bool domask, const int tkbase, const int tqbase, const int comp, const int fr, const int fq) {
    f32x4 s[4][2];
    const f32x4 negm = (f32x4){-mfix, -mfix, -mfix, -mfix};
    __builtin_amdgcn_s_setprio(1);
#pragma unroll
    for (int kt = 0; kt < 4; ++kt) {
      if (MODE == 0) {
        bf16x8 a0 = *(const bf16x8*)(kb + (kt * 16 + fr) * 128 + (((0 * 4 + fq) ^ (fr & 7)) * 16));
        bf16x8 a1 = *(const bf16x8*)(kb + (kt * 16 + fr) * 128 + (((1 * 4 + fq) ^ (fr & 7)) * 16));
        s[kt][0] = MFMA(a0, qf[0][0], negm); s[kt][1] = MFMA(a0, qf[1][0], negm);
        s[kt][0] = MFMA(a1, qf[0][1], s[kt][0]); s[kt][1] = MFMA(a1, qf[1][1], s[kt][1]);
      } else {
        bf16x8 a = *(const bf16x8*)(kb + (kt * 16 + fr) * 128 + (((comp * 4 + fq) ^ (fr & 7)) * 16));
        s[kt][0] = MFMA(a, qf[0][0], negm); s[kt][1] = MFMA(a, qf[1][0], negm);
      }
    }
    __builtin_amdgcn_s_setprio(0);
    bf16x8 pb[2][2];
    union { bf16x8 v; unsigned u[4]; } onesu; onesu.u[0] = onesu.u[1] = onesu.u[2] = onesu.u[3] = 0x3f803f80u;
    if (domask) {
#pragma unroll
      for (int qt = 0; qt < 2; ++qt)
#pragma unroll
        for (int kt = 0; kt < 4; ++kt)
#pragma unroll
          for (int r = 0; r < 4; ++r) { int tk = tkbase + kt * 16 + r; int tq = tqbase + qt * 16; int d = tq - tk; if (d > 128 || d < -128) s[kt][qt][r] = -1e30f; }
    }
#pragma unroll
    for (int qt = 0; qt < 2; ++qt) {
#pragma unroll
      for (int kt = 0; kt < 4; ++kt)
#pragma unroll
        for (int r = 0; r < 4; ++r) s[kt][qt][r] = __builtin_amdgcn_exp2f(s[kt][qt][r]);
#pragma unroll
      for (int kk = 0; kk < 2; ++kk) {
        union { bf16x8 v; unsigned u[4]; } pk;
        pk.u[0] = pack2(s[2 * kk][qt][0], s[2 * kk][qt][1]); pk.u[1] = pack2(s[2 * kk][qt][2], s[2 * kk][qt][3]);
        pk.u[2] = pack2(s[2 * kk + 1][qt][0], s[2 * kk + 1][qt][1]); pk.u[3] = pack2(s[2 * kk + 1][qt][2], s[2 * kk + 1][qt][3]);
        pb[qt][kk] = pk.v;
        osum[qt] = MFMA(onesu.v, pk.v, osum[qt]);
      }
    }
    __builtin_amdgcn_s_setprio(1);
#pragma unroll
    for (int kk = 0; kk < 2; ++kk)
#pragma unroll
      for (int mt = 0; mt < 4; ++mt) {
        const int voff = (mt * 16 + fr) * 128 + (((kk * 4 + (fq >> 1)) ^ (fr >> 1)) * 16) + (fq & 1) * 8;
        s16x4 lo = *(const s16x4*)(vb + voff);
        s16x4 hi = *(const s16x4*)(vb + (voff ^ 32));
        bf16x8 a = __builtin_shufflevector(lo, hi, 0, 1, 2, 3, 4, 5, 6, 7);
        o[mt][0] = MFMA(a, pb[0][kk], o[mt][0]); o[mt][1] = MFMA(a, pb[1][kk], o[mt][1]);
      }
    __builtin_amdgcn_s_setprio(0);
}

template <int MODE>
DI void attn_item(const Params& P, int l, int g, int item, char* smem, char* smem1) {
  const int tid = get_tid(), lane = tid & 63, w = tid >> 6, fr = lane & 15, fq = lane >> 4;
  int hv_ = (int)(threadIdx.x >> 8); asm volatile("" : "+v"(hv_)); const int half = __builtin_amdgcn_readfirstlane(hv_);
  const u16* Pb = (const u16*)(P.ws + OFF_PB);
  const u16* VT = (const u16*)(P.ws + OFF_VT);
  u16* MIX = (u16*)(P.ws + OFF_HB);
  int sc, h, qb;
  if (MODE == 0) { sc = ((item >> 7) + 2) % 3; int r = item & 127; h = r & 3; qb = r >> 2; } else { sc = ((item >> 8) + 2) % 3; int r = item & 255; h = r & 3; qb = r >> 2; }
  const int gsc = g * 3 + sc; const bool samp = gsc >= 2; const int b = gsc - 2;
  const int QB = (MODE == 0) ? 128 : 64;
  const int ltq0 = sc * 4096 + qb * QB;
  int t0, kstart_l, nloc, nctx, kstart_t;
  if (samp) {
    t0 = qb * QB;
    if (MODE == 0) { kstart_t = t0 - 128 < 0 ? 0 : t0 - 128; int kend = t0 + 256 > 4096 ? 4096 : t0 + 256; nloc = (kend - kstart_t) >> 6; }
    else { kstart_t = 0; nloc = 64; }
    nctx = 8; kstart_l = sc * 4096 + kstart_t;
  } else { t0 = ltq0 & 255; kstart_t = 0; kstart_l = ltq0 & ~255; nloc = 4; nctx = 0; }
  const int ntile = nloc + nctx;
  const int kvhead = (MODE == 0) ? (VH_WIN + (h >> 1)) : (VH_DIFF + h);
  const int kcol = (MODE == 0) ? (PC_WK + (h >> 1) * 64) : (PC_DK + h * 64);
  const u16* ctxK; const u16* ctxV;
  if (MODE == 0) { ctxK = (const u16*)(P.ws + OFF_CWK) + (size_t)((l * 4 + b) * 2 + (h >> 1)) * 512 * 64; ctxV = (const u16*)(P.ws + OFF_CWVT) + (size_t)((l * 4 + b) * 2 + (h >> 1)) * 64 * 512; }
  else { ctxK = (const u16*)(P.ws + OFF_CDK) + (size_t)((l * 4 + b) * 4 + h) * 2 * 512 * 32; ctxV = (const u16*)(P.ws + OFF_CDVT) + (size_t)((l * 4 + b) * 4 + h) * 64 * 512; }
  const int comp = (MODE == 1) ? (w & 1) : 0;
  const int qoff = (MODE == 0) ? 32 * w : 32 * (w >> 1);
  bf16x8 qf[2][2];
#pragma unroll
  for (int qt = 0; qt < 2; ++qt) {
    const u16* qp = Pb + (size_t)(ltq0 + qoff + qt * 16 + fr) * PW;
    if (MODE == 0) { qf[qt][0] = *(const bf16x8*)(qp + PC_WQ + h * 64 + fq * 8); qf[qt][1] = *(const bf16x8*)(qp + PC_WQ + h * 64 + 32 + fq * 8); }
    else { qf[qt][0] = *(const bf16x8*)(qp + PC_DQ + h * 64 + comp * 32 + fq * 8); qf[qt][1] = qf[qt][0]; }
  }
  const float scl = (MODE == 0 ? 0.125f : 0.17677669529663687f) * LOG2E;
  float mfix;
  {
    float gq = 0.f, gk = 0.f;
    if (MODE == 0) { for (int i = 0; i < 64; ++i) { gq = fmaxf(gq, fabsf(P.win_q_norm[l * 64 + i])); gk = fmaxf(gk, fabsf(P.win_k_norm[l * 64 + i])); } }
    else { for (int i = 0; i < 32; ++i) { gq = fmaxf(gq, fabsf(P.diff_q_norm[l * 32 + i])); gk = fmaxf(gk, fabsf(P.diff_k_norm[l * 32 + i])); } }
    const float dn = (MODE == 0) ? 8.f : 5.656854249492381f;
    float kn = dn * gk;
    if (samp) { const float* KN = (const float*)(P.ws + OFF_KN); const float k2 = (MODE == 0) ? KN[(l * 4 + b) * 2 + (h >> 1)] : KN[16 + ((l * 4 + b) * 4 + h) * 2 + comp]; kn = fmaxf(kn, sqrtf(k2)); }
    mfix = scl * dn * gq * kn;
  }
  f32x4 osum[2];
  if (MODE == 0 && half == 0) { const float ps = __builtin_amdgcn_exp2f(P.win_sink[l * 4 + h] * LOG2E - mfix); osum[0] = osum[1] = (f32x4){ps, ps, ps, ps}; }
  else { osum[0] = osum[1] = (f32x4){0.f, 0.f, 0.f, 0.f}; }
  f32x4 o[4][2];
#pragma unroll
  for (int i = 0; i < 4; ++i) { o[i][0] = (f32x4){0.f, 0.f, 0.f, 0.f}; o[i][1] = (f32x4){0.f, 0.f, 0.f, 0.f}; }
  char* sK = smem; float* sX = (float*)smem;
  const u16 *bkl[2], *bvl[2], *bkc[2], *bvc[2];
#pragma unroll
  for (int I = 0; I < 2; ++I) {
    const int u_ = (I * 4 + w) * 64 + lane; const int row_ = u_ >> 3, cp_ = u_ & 7;
    const int chk_ = cp_ ^ (row_ & 7), chv_ = cp_ ^ ((row_ >> 1) & 7);
    bkl[I] = Pb + (size_t)(kstart_l + row_) * PW + kcol + chk_ * 8;
    bvl[I] = VT + (size_t)(kvhead * 64 + row_) * GT + kstart_l + chv_ * 8;
    bkc[I] = (MODE == 0) ? ctxK + (size_t)row_ * 64 + chk_ * 8 : ctxK + (size_t)(chk_ >> 2) * 512 * 32 + (size_t)row_ * 32 + (chk_ & 3) * 8;
    bvc[I] = ctxV + (size_t)row_ * 512 + chv_ * 8;
  }
#define ATT_DMA1(I, J, SLOT) { \
      const int u_ = ((I) * 4 + w) * 64 + lane; \
      const u16 *kp_, *vp_; \
      if ((J) < nloc) { kp_ = bkl[I] + (size_t)(J) * (64 * PW); vp_ = bvl[I] + (J) * 64; } \
      else { const int jc_ = (J) - nloc; kp_ = bkc[I] + jc_ * ((MODE == 0) ? 4096 : 2048); vp_ = bvc[I] + jc_ * 64; } \
      __builtin_amdgcn_global_load_lds((const unsigned*)kp_, (__attribute__((address_space(3))) unsigned*)(sK + (SLOT) * 16384 + u_ * 16), 16, 0, 0); \
      __builtin_amdgcn_global_load_lds((const unsigned*)vp_, (__attribute__((address_space(3))) unsigned*)(sK + (SLOT) * 16384 + 8192 + u_ * 16), 16, 0, 0); }
#define dma_tile(J, SLOT) { ATT_DMA1(0, J, SLOT) ATT_DMA1(1, J, SLOT) }
  __syncthreads();
  const bool maskable = (MODE == 0) && samp;
  const int tqbase = t0 + qoff + fr;
  const int jbeg = half ? (ntile >> 1) : 0, jend = half ? ntile : (ntile >> 1);
  dma_tile(jbeg, 0);
  if (jbeg + 1 < jend) dma_tile(jbeg + 1, 1);
  __syncthreads();
  for (int tt = jbeg, par = 0; tt < jend; tt += 2, par ^= 2) {
    if (tt + 2 < jend) dma_tile(tt + 2, (par ^ 2));
    if (tt + 3 < jend) dma_tile(tt + 3, (par ^ 2) + 1);
    const char* kb0 = sK + par * 16384;
    attn_compute<MODE>(kb0, kb0 + 8192, qf, o, mfix, osum, scl, maskable && (tt < nloc), kstart_t + tt * 64 + fq * 4, tqbase, comp, fr, fq);
    if (tt + 1 < jend)
      attn_compute<MODE>(kb0 + 16384, kb0 + 16384 + 8192, qf, o, mfix, osum, scl, maskable && (tt + 1 < nloc), kstart_t + (tt + 1) * 64 + fq * 4, tqbase, comp, fr, fq);
    __syncthreads();
  }
#undef dma_tile
#undef ATT_DMA1
  {
    float4* mb = (float4*)smem1 + (size_t)tid * 10;
    if (half == 1) {
#pragma unroll
      for (int mt = 0; mt < 4; ++mt) { mb[mt * 2] = make_float4(o[mt][0][0], o[mt][0][1], o[mt][0][2], o[mt][0][3]); mb[mt * 2 + 1] = make_float4(o[mt][1][0], o[mt][1][1], o[mt][1][2], o[mt][1][3]); }
      mb[8] = make_float4(osum[0][0], osum[1][0], 0.f, 0.f);
    }
    __syncthreads();
    if (half == 0) {
      const float4 st = mb[8];
      osum[0][0] += st.x; osum[1][0] += st.y;
#pragma unroll
      for (int qt = 0; qt < 2; ++qt)
#pragma unroll
        for (int mt = 0; mt < 4; ++mt) { const float4 o1 = mb[mt * 2 + qt]; o[mt][qt][0] += o1.x; o[mt][qt][1] += o1.y; o[mt][qt][2] += o1.z; o[mt][qt][3] += o1.w; }
    }
  }
#pragma unroll
  for (int qt = 0; qt < 2; ++qt) {
    const float inv = 1.f / osum[qt][0];
#pragma unroll
    for (int mt = 0; mt < 4; ++mt) o[mt][qt] *= inv;
  }
  if (MODE == 0) {
    if (half == 0) {
#pragma unroll
    for (int qt = 0; qt < 2; ++qt) {
      u16* dst = MIX + (size_t)(ltq0 + qoff + qt * 16 + fr) * 1024 + 256 + h * 64;
#pragma unroll
      for (int mt = 0; mt < 4; ++mt) { uint2 v; v.x = pack2(o[mt][qt][0], o[mt][qt][1]); v.y = pack2(o[mt][qt][2], o[mt][qt][3]); *(uint2*)(dst + mt * 16 + fq * 4) = v; }
    }
    }
  } else {
    float* xb = sX + (w >> 1) * (32 * 68);
    if (comp == 1 && half == 0) {
#pragma unroll
      for (int qt = 0; qt < 2; ++qt)
#pragma unroll
        for (int mt = 0; mt < 4; ++mt) *(float4*)(xb + (qt * 16 + fr) * 68 + mt * 16 + fq * 4) = make_float4(o[mt][qt][0], o[mt][qt][1], o[mt][qt][2], o[mt][qt][3]);
    }
    __syncthreads();
    if (comp == 0 && half == 0) {
      float d1 = 0.f, d2 = 0.f;
      const float* dl = P.diff_lambda + l * 128;
#pragma unroll
      for (int i = 0; i < 32; ++i) { d1 += dl[i] * dl[32 + i]; d2 += dl[64 + i] * dl[96 + i]; }
      const float lam_init = 0.8f - 0.6f * __expf(-0.3f * (float)l);
      const float lam = __expf(d1) - __expf(d2) + lam_init;
#pragma unroll
      for (int qt = 0; qt < 2; ++qt) {
        float ss = 0.f;
#pragma unroll
        for (int mt = 0; mt < 4; ++mt) {
          float4 o2 = *(const float4*)(xb + (qt * 16 + fr) * 68 + mt * 16 + fq * 4);
          o[mt][qt][0] -= lam * o2.x; o[mt][qt][1] -= lam * o2.y; o[mt][qt][2] -= lam * o2.z; o[mt][qt][3] -= lam * o2.w;
#pragma unroll
          for (int r = 0; r < 4; ++r) ss += o[mt][qt][r] * o[mt][qt][r];
        }
        ss += __shfl_xor(ss, 16); ss += __shfl_xor(ss, 32);
        const float rs = rsqrtf(ss * (1.f / 64.f) + EPS) * (1.f - lam_init);
        u16* dst = MIX + (size_t)(ltq0 + qoff + qt * 16 + fr) * 1024 + 512 + h * 64;
#pragma unroll
        for (int mt = 0; mt < 4; ++mt) {
          float4 gn = *(const float4*)(P.diff_norm_g + l * 256 + h * 64 + mt * 16 + fq * 4);
          uint2 v; v.x = pack2(o[mt][qt][0] * rs * gn.x, o[mt][qt][1] * rs * gn.y); v.y = pack2(o[mt][qt][2] * rs * gn.z, o[mt][qt][3] * rs * gn.w);
          *(uint2*)(dst + mt * 16 + fq * 4) = v;
        }
      }
    }
  }
}

DI void gla_state_item(const Params& P, int l, int g, int stream, int chunk, int h, char* smem) {
  const int tid = get_tid(), lane = tid & 63, w = tid >> 6, fr = lane & 15, fq = lane >> 4;
  const u16* Pb = (const u16*)(P.ws + OFF_PB);
  const u16* VT = (const u16*)(P.ws + OFF_VT);
  const float* LF = (const float*)(P.ws + OFF_LF);
  u16* sV = (u16*)smem; float* sCf = (float*)(smem + 9216); float* sCb = (float*)(smem + 26624); u16* sKf = (u16*)(smem + 44032); u16* sKb = (u16*)(smem + 53248);
  const int ltok0 = chunk * 64;
  const int vh = (stream == 0 ? VH_RET : VH_HGRN) + h;
  __syncthreads();
#pragma unroll
  for (int i = 0; i < 2; ++i) { const int c = tid + 256 * i; const int dv = c >> 3, ch = c & 7; *(uint4*)((char*)sV + dv * 144 + ch * 16) = *(const uint4*)(VT + (size_t)(vh * 64 + dv) * GT + ltok0 + ch * 8); }
  if (stream == 0) {
    const float lgf = -__expf(P.ret_decay[(l * 2 + 0) * 4 + h]), lgb = -__expf(P.ret_decay[(l * 2 + 1) * 4 + h]);
#pragma unroll
    for (int i = 0; i < 16; ++i) { const int e = tid + 256 * i; const int s = e >> 6, d = e & 63; sCf[s * 68 + d] = (float)(s + 1) * lgf; sCb[s * 68 + d] = (float)(s + 1) * lgb; }
    __syncthreads();
  } else {
#pragma unroll
    for (int i = 0; i < 4; ++i) {
      const int c = tid + 256 * i; const int s = c >> 4, d4 = (c & 15) * 4;
      *(float4*)(sCf + s * 68 + d4) = *(const float4*)(LF + ((size_t)0 * GT + ltok0 + s) * 256 + h * 64 + d4);
      *(float4*)(sCb + s * 68 + d4) = *(const float4*)(LF + ((size_t)1 * GT + ltok0 + s) * 256 + h * 64 + d4);
    }
    __syncthreads();
    const int d = tid & 63, part = tid >> 6;
    float af = 0.f, ab = 0.f;
#pragma unroll
    for (int i = 0; i < 16; ++i) { const int s = part * 16 + i; af += sCf[s * 68 + d]; sCf[s * 68 + d] = af; ab += sCb[s * 68 + d]; sCb[s * 68 + d] = ab; }
    __syncthreads();
    float of = 0.f, ob = 0.f;
    for (int p = 0; p < part; ++p) { of += sCf[(p * 16 + 15) * 68 + d]; ob += sCb[(p * 16 + 15) * 68 + d]; }
    __syncthreads();
#pragma unroll
    for (int i = 0; i < 16; ++i) { const int s = part * 16 + i; sCf[s * 68 + d] += of; sCb[s * 68 + d] += ob; }
    __syncthreads();
  }
  {
    const int s = tid & 63, db = (tid >> 6) * 16;
    const u16* kp = Pb + (size_t)(ltok0 + s) * PW + PC_RK + h * 64 + db;
#pragma unroll
    for (int i = 0; i < 16; ++i) {
      const int d = db + i;
      const float cf = sCf[s * 68 + d], cfp = s > 0 ? sCf[(s - 1) * 68 + d] : 0.f, lastf = sCf[63 * 68 + d];
      const float cbv = sCb[s * 68 + d], cbp = s > 0 ? sCb[(s - 1) * 68 + d] : 0.f;
      float kf, kb;
      if (stream == 0) { kf = bf2f(kp[i]); kb = kf; } else { kf = 1.f - __expf(cf - cfp); kb = 1.f - __expf(cbv - cbp); }
      sKf[d * 72 + s] = f2bf(kf * __expf(lastf - cf));
      sKb[d * 72 + s] = f2bf(kb * __expf(cbp));
    }
  }
  __syncthreads();
  float* ST = (float*)(P.ws + OFF_ST); float* DEC = (float*)(P.ws + OFF_DEC);
#pragma unroll
  for (int dir = 0; dir < 2; ++dir) {
    const u16* sK = dir ? sKb : sKf;
    float* dst = ST + ((size_t)((stream * NCH + chunk) * 2 + dir) * 4 + h) * 4096;
#pragma unroll
    for (int nt = 0; nt < 4; ++nt) {
      f32x4 acc = (f32x4){0.f, 0.f, 0.f, 0.f};
#pragma unroll
      for (int ks = 0; ks < 2; ++ks) {
        bf16x8 a = *(const bf16x8*)((const char*)sV + (16 * w + fr) * 144 + (ks * 4 + fq) * 16);
        bf16x8 bb = *(const bf16x8*)((const char*)sK + (nt * 16 + fr) * 144 + (ks * 4 + fq) * 16);
        acc = MFMA(bb, a, acc);
      }
      *(float4*)(dst + (16 * w + fr) * 64 + nt * 16 + fq * 4) = make_float4(acc[0], acc[1], acc[2], acc[3]);
    }
  }
  if (tid < 128) {
    const int dir = tid >> 6, d = tid & 63;
    DEC[((size_t)((stream * NCH + chunk) * 2 + dir) * 4 + h) * 64 + d] = __expf((dir ? sCb : sCf)[63 * 68 + d]);
  }
}

DI void scan_phase(const Params& P, int l, int g) {
  const int tid = get_tid();
  const int nseq = (g == 0) ? 33 : 3;
  float* ST = (float*)(P.ws + OFF_ST); const float* DEC = (const float*)(P.ws + OFF_DEC);
  for (int it = get_vb(); it < nseq * 128; it += NVB) {
    const int sl = it >> 7, r = it & 127;
    const int stream = r >> 6, dir = (r >> 5) & 1, h = (r >> 3) & 3, slice = r & 7;
    const int e = slice * 512 + tid; const int dv = e >> 6, dk = e & 63;
    int chunk0, nch, b; bool samp;
    if (g == 0) { if (sl < 32) { samp = false; b = sl; chunk0 = sl * 4; nch = 4; } else { samp = true; b = 0; chunk0 = 128; nch = 64; } }
    else { samp = true; b = 1 + sl; chunk0 = sl * 64; nch = 64; }
    float s0v = 0.f, s1v = 0.f;
    if (samp) { const float* s0 = (stream == 0 ? P.state_ret : P.state_hgrn) + ((size_t)((b * 2 + l) * 2 + dir) * 4 + h) * 4096 + dk * 64 + dv; s0v = s0[0]; s1v = s0[4]; }
    for (int c0 = 0; c0 < nch; c0 += 8) {
      float u0[8], u1[8], d[8]; size_t idx[8];
#pragma unroll
      for (int q = 0; q < 8; ++q) {
        const int ci = c0 + q; const int cc = ci < nch ? ci : nch - 1; const int c = dir == 0 ? chunk0 + cc : chunk0 + nch - 1 - cc;
        const size_t base = (size_t)((stream * NCH + c) * 2 + dir) * 4 + h;
        idx[q] = base * 4096 + e; u0[q] = ST[idx[q]]; u1[q] = ST[idx[q] + 256]; d[q] = DEC[base * 64 + dk];
      }
#pragma unroll
      for (int q = 0; q < 8; ++q) { if (c0 + q < nch) { ST[idx[q]] = s0v; ST[idx[q] + 256] = s1v; s0v = d[q] * s0v + u0[q]; s1v = d[q] * s1v + u1[q]; } }
    }
    if (!samp) { float* so = P.out + (stream == 0 ? O_SRET : O_SHG) + ((size_t)((b * 2 + l) * 2 + dir) * 4 + h) * 4096 + dk * 64 + dv; so[0] = s0v; so[4] = s1v; }
  }
}

DI void gla_out_item(const Params& P, int l, int g, int stream, int chunk, int h, char* smem) {
  const int tid = get_tid(), lane = tid & 63, w = tid >> 6, fr = lane & 15, fq = lane >> 4;
  const u16* Pb = (const u16*)(P.ws + OFF_PB);
  const u16* VT = (const u16*)(P.ws + OFF_VT);
  const float* LF = (const float*)(P.ws + OFF_LF);
  const float* ST = (const float*)(P.ws + OFF_ST);
  u16* MIX = (u16*)(P.ws + OFF_HB);
  char* sQ = smem; char* sK = smem + 8192; float* sC = (float*)(smem + 16384); char* sV = smem + 33792; char* sS = smem + 43008;
  const int ltok0 = chunk * 64;
  const int qcol = (stream == 0 ? PC_RQ : PC_HQ) + h * 64, gcol = (stream == 0 ? PC_RG : PC_HG) + h * 64;
  const int vh = (stream == 0 ? VH_RET : VH_HGRN) + h;
  f32x4 of[4];
#pragma unroll
  for (int i = 0; i < 4; ++i) of[i] = (f32x4){0.f, 0.f, 0.f, 0.f};
#pragma unroll 1
  for (int pass = 0; pass < 2; ++pass) {
    __syncthreads();
#pragma unroll
    for (int i = 0; i < 2; ++i) {
      const int c = tid + 256 * i; const int row = c >> 3, ch = c & 7;
      const int tok = pass ? ltok0 + 63 - row : ltok0 + row;
      *(uint4*)(sQ + row * 128 + ((ch ^ (row & 7)) * 16)) = *(const uint4*)(Pb + (size_t)tok * PW + qcol + ch * 8);
      if (stream == 0) *(uint4*)(sK + row * 128 + ((ch ^ (row & 7)) * 16)) = *(const uint4*)(Pb + (size_t)tok * PW + PC_RK + h * 64 + ch * 8);
      uint4 vv = *(const uint4*)(VT + (size_t)(vh * 64 + row) * GT + ltok0 + ch * 8);
      if (pass) {
        uint4 t;
        t.x = (vv.w >> 16) | (vv.w << 16); t.y = (vv.z >> 16) | (vv.z << 16); t.z = (vv.y >> 16) | (vv.y << 16); t.w = (vv.x >> 16) | (vv.x << 16);
        *(uint4*)(sV + row * 144 + (7 - ch) * 16) = t;
      } else *(uint4*)(sV + row * 144 + ch * 16) = vv;
    }
    {
      const int dv = tid >> 2, part = tid & 3;
      const float* sp = ST + ((size_t)((stream * NCH + chunk) * 2 + pass) * 4 + h) * 4096 + dv * 64 + part * 16;
      float t[16];
#pragma unroll
      for (int i = 0; i < 4; ++i) { float4 f = *(const float4*)(sp + 4 * i); t[4 * i] = f.x; t[4 * i + 1] = f.y; t[4 * i + 2] = f.z; t[4 * i + 3] = f.w; }
#pragma unroll
      for (int hh = 0; hh < 2; ++hh) {
        uint4 o4; o4.x = pack2(t[8 * hh], t[8 * hh + 1]); o4.y = pack2(t[8 * hh + 2], t[8 * hh + 3]); o4.z = pack2(t[8 * hh + 4], t[8 * hh + 5]); o4.w = pack2(t[8 * hh + 6], t[8 * hh + 7]);
        const int ch = part * 2 + hh;
        *(uint4*)(sS + dv * 128 + ((ch ^ (dv & 7)) * 16)) = o4;
      }
    }
    if (stream == 0) {
      const float lg = -__expf(P.ret_decay[(l * 2 + pass) * 4 + h]);
#pragma unroll
      for (int i = 0; i < 16; ++i) { const int e = tid + 256 * i; const int s = e >> 6, d = e & 63; sC[s * 68 + d] = (float)(s + 1) * lg; }
      __syncthreads();
    } else {
#pragma unroll
      for (int i = 0; i < 4; ++i) {
        const int c = tid + 256 * i; const int row = c >> 4, d4 = (c & 15) * 4;
        const int tok = pass ? ltok0 + 63 - row : ltok0 + row;
        *(float4*)(sC + row * 68 + d4) = *(const float4*)(LF + ((size_t)pass * GT + tok) * 256 + h * 64 + d4);
      }
      __syncthreads();
      {
        const int row = tid >> 2, part = tid & 3;
        float t[16];
#pragma unroll
        for (int i = 0; i < 16; ++i) t[i] = 1.f - __expf(sC[row * 68 + part * 16 + i]);
#pragma unroll
        for (int hh = 0; hh < 2; ++hh) {
          uint4 o4; o4.x = pack2(t[8 * hh], t[8 * hh + 1]); o4.y = pack2(t[8 * hh + 2], t[8 * hh + 3]); o4.z = pack2(t[8 * hh + 4], t[8 * hh + 5]); o4.w = pack2(t[8 * hh + 6], t[8 * hh + 7]);
          const int ch = part * 2 + hh;
          *(uint4*)(sK + row * 128 + ((ch ^ (row & 7)) * 16)) = o4;
        }
      }
      __syncthreads();
      const int d = tid & 63, part = tid >> 6;
      float a = 0.f;
#pragma unroll
      for (int i = 0; i < 16; ++i) { const int s = part * 16 + i; a += sC[s * 68 + d]; sC[s * 68 + d] = a; }
      __syncthreads();
      float off = 0.f;
      for (int p = 0; p < part; ++p) off += sC[(p * 16 + 15) * 68 + d];
      __syncthreads();
#pragma unroll
      for (int i = 0; i < 16; ++i) { const int s = part * 16 + i; sC[s * 68 + d] += off; }
      __syncthreads();
    }
    const int j = pass ? 3 - w : w;
    const int rowq = 16 * j + fr;
    bf16x8 qB[2], qI[2];
    float cj[2][8];
#pragma unroll
    for (int ks = 0; ks < 2; ++ks) {
      const int d0 = ks * 32 + fq * 8;
      bf16x8 q8 = *(const bf16x8*)(sQ + rowq * 128 + (((ks * 4 + fq) ^ (rowq & 7)) * 16));
      float4 c0 = *(const float4*)(sC + rowq * 68 + d0), c1 = *(const float4*)(sC + rowq * 68 + d0 + 4);
      float cq[8] = {c0.x, c0.y, c0.z, c0.w, c1.x, c1.y, c1.z, c1.w};
      if (j > 0) {
        float4 j0 = *(const float4*)(sC + (16 * j - 1) * 68 + d0), j1 = *(const float4*)(sC + (16 * j - 1) * 68 + d0 + 4);
        cj[ks][0] = j0.x; cj[ks][1] = j0.y; cj[ks][2] = j0.z; cj[ks][3] = j0.w; cj[ks][4] = j1.x; cj[ks][5] = j1.y; cj[ks][6] = j1.z; cj[ks][7] = j1.w;
      } else {
#pragma unroll
        for (int e = 0; e < 8; ++e) cj[ks][e] = 0.f;
      }
      union { bf16x8 v; unsigned u[4]; } ub, ui;
#pragma unroll
      for (int e = 0; e < 4; ++e) {
        float q0 = bf2f((u16)q8[2 * e]), q1 = bf2f((u16)q8[2 * e + 1]);
        ub.u[e] = pack2(q0 * __expf(cq[2 * e] - cj[ks][2 * e]), q1 * __expf(cq[2 * e + 1] - cj[ks][2 * e + 1]));
        ui.u[e] = pack2(q0 * __expf(cq[2 * e]), q1 * __expf(cq[2 * e + 1]));
      }
      qB[ks] = ub.v; qI[ks] = ui.v;
    }
    f32x4 st[4];
#pragma unroll
    for (int i = 0; i < 4; ++i) {
      st[i] = (f32x4){0.f, 0.f, 0.f, 0.f};
      if (i <= j) {
        const int rowk = 16 * i + fr;
#pragma unroll
        for (int ks = 0; ks < 2; ++ks) {
          const int d0 = ks * 32 + fq * 8;
          bf16x8 k8 = *(const bf16x8*)(sK + rowk * 128 + (((ks * 4 + fq) ^ (rowk & 7)) * 16));
          float4 c0 = *(const float4*)(sC + rowk * 68 + d0), c1 = *(const float4*)(sC + rowk * 68 + d0 + 4);
          float ck[8] = {c0.x, c0.y, c0.z, c0.w, c1.x, c1.y, c1.z, c1.w};
          union { bf16x8 v; unsigned u[4]; } ua;
#pragma unroll
          for (int e = 0; e < 4; ++e) {
            float k0 = bf2f((u16)k8[2 * e]), k1 = bf2f((u16)k8[2 * e + 1]);
            ua.u[e] = pack2(k0 * __expf(fminf(cj[ks][2 * e] - ck[2 * e], 80.f)), k1 * __expf(fminf(cj[ks][2 * e + 1] - ck[2 * e + 1], 80.f)));
          }
          st[i] = MFMA(ua.v, qB[ks], st[i]);
        }
        if (i == j) {
#pragma unroll
          for (int r = 0; r < 4; ++r) if (fq * 4 + r > fr) st[i][r] = 0.f;
        }
      }
    }
    f32x4 o[4];
#pragma unroll
    for (int i = 0; i < 4; ++i) o[i] = (f32x4){0.f, 0.f, 0.f, 0.f};
#pragma unroll
    for (int kk = 0; kk < 2; ++kk) {
      if (2 * kk <= j) {
        union { bf16x8 v; unsigned u[4]; } pk;
        pk.u[0] = pack2(st[2 * kk][0], st[2 * kk][1]); pk.u[1] = pack2(st[2 * kk][2], st[2 * kk][3]);
        pk.u[2] = pack2(st[2 * kk + 1][0], st[2 * kk + 1][1]); pk.u[3] = pack2(st[2 * kk + 1][2], st[2 * kk + 1][3]);
#pragma unroll
        for (int mt = 0; mt < 4; ++mt) {
          s16x4 lo = *(const s16x4*)(sV + (mt * 16 + fr) * 144 + (kk * 32 + fq * 4) * 2);
          s16x4 hi = *(const s16x4*)(sV + (mt * 16 + fr) * 144 + (kk * 32 + 16 + fq * 4) * 2);
          bf16x8 a = __builtin_shufflevector(lo, hi, 0, 1, 2, 3, 4, 5, 6, 7);
          o[mt] = MFMA(a, pk.v, o[mt]);
        }
      }
    }
#pragma unroll
    for (int ks = 0; ks < 2; ++ks)
#pragma unroll
      for (int mt = 0; mt < 4; ++mt) {
        const int rs = mt * 16 + fr;
        bf16x8 a = *(const bf16x8*)(sS + rs * 128 + (((ks * 4 + fq) ^ (rs & 7)) * 16));
        o[mt] = MFMA(a, qI[ks], o[mt]);
      }
    if (pass == 0) {
#pragma unroll
      for (int mt = 0; mt < 4; ++mt) of[mt] = o[mt];
    } else {
      const int srcl = (lane & 48) | (15 - fr);
#pragma unroll
      for (int mt = 0; mt < 4; ++mt)
#pragma unroll
        for (int r = 0; r < 4; ++r) of[mt][r] += __shfl(o[mt][r], srcl);
    }
  }
  const int tok = ltok0 + 16 * w + fr;
  float ss = 0.f;
#pragma unroll
  for (int mt = 0; mt < 4; ++mt)
#pragma unroll
    for (int r = 0; r < 4; ++r) ss += of[mt][r] * of[mt][r];
  ss += __shfl_xor(ss, 16); ss += __shfl_xor(ss, 32);
  const float rs = rsqrtf(ss * (1.f / 64.f) + EPS);
  const float* gnp = (stream == 0 ? P.ret_norm_g : P.hgrn_norm_g) + l * 256 + h * 64;
  u16* dst = MIX + (size_t)tok * 1024 + (stream == 0 ? 0 : 768) + h * 64;
  float4 gnv[4]; uint2 gtv[4];
#pragma unroll
  for (int mt = 0; mt < 4; ++mt) { const int dv = mt * 16 + fq * 4; gnv[mt] = *(const float4*)(gnp + dv); gtv[mt] = *(const uint2*)(Pb + (size_t)tok * PW + gcol + dv); }
#pragma unroll
  for (int mt = 0; mt < 4; ++mt) {
    const int dv = mt * 16 + fq * 4;
    const float4 gn = gnv[mt]; const uint2 gt = gtv[mt];
    float g0 = bf2f((u16)(gt.x & 0xffff)), g1 = bf2f((u16)(gt.x >> 16)), g2 = bf2f((u16)(gt.y & 0xffff)), g3 = bf2f((u16)(gt.y >> 16));
    uint2 v; v.x = pack2(of[mt][0] * rs * gn.x * g0, of[mt][1] * rs * gn.y * g1); v.y = pack2(of[mt][2] * rs * gn.z * g2, of[mt][3] * rs * gn.w * g3);
    *(uint2*)(dst + dv) = v;
  }
}

DI void mix1_phase(const Params& P, int l, int g, char* smem, char* smem1) {
  constexpr int N_DIFF = 768, N_WIN = 384, N_ST = 2 * NCH * 4;
  int bid = blockIdx.x; asm volatile("" : "+s"(bid));
  for (int it = bid; it < N_DIFF; it += gridDim.x) attn_item<1>(P, l, g, it, smem, smem1);
  for (int it = bid; it < N_WIN; it += gridDim.x) attn_item<0>(P, l, g, it, smem, smem1);
  for (int it = get_vb(); it < N_ST; it += NVB) { int stream = it / (NCH * 4); int rr = it % (NCH * 4); gla_state_item(P, l, g, stream, rr >> 2, rr & 3, smem); }
}
DI void mix3_phase(const Params& P, int l, int g, char* smem) {
  for (int it = get_vb(); it < 2 * NCH * 4; it += NVB) { int stream = it / (NCH * 4); int rr = it % (NCH * 4); gla_out_item(P, l, g, stream, rr >> 2, rr & 3, smem); }
}

#define XB_TMO      128
#define XB_XCNT(j)  (256  + 64 * (j))
#define XB_XSUB(j)  (1280 + 64 * (j))
#define XB_XGEN(j)  (2304 + 64 * (j))
#define XB_TOP      3328
#define XB_TOPGEN   3392
#define XCD_BAR_WORDS 3456
#define XB_SPIN_CAP (1u << 22)
#define LAS __attribute__((address_space(3)))
DI unsigned xb_ld(unsigned* p) { return __hip_atomic_load(p, __ATOMIC_RELAXED, __HIP_MEMORY_SCOPE_AGENT); }
DI unsigned xb_add(unsigned* p, unsigned v) { return __hip_atomic_fetch_add(p, v, __ATOMIC_RELAXED, __HIP_MEMORY_SCOPE_AGENT); }
DI unsigned xb_xcc_id() { return (unsigned)__builtin_amdgcn_s_getreg((3 << 11) | 20) & 0xFu; }
#define XB_SPIN(cond, bar) do { unsigned _sp = 0; while (cond) { __builtin_amdgcn_s_sleep(1); \
    if ((++_sp & 255u) == 0u) { if (xb_ld(&(bar)[XB_TMO])) break; if (_sp > XB_SPIN_CAP) { atomicAdd(&(bar)[XB_TMO], 1u); break; } } } } while (0)
struct XcdBarrier { unsigned* bar; unsigned x; volatile LAS unsigned* st; };
DI XcdBarrier xcd_barrier_post(unsigned* bar, volatile LAS unsigned* st) {
  XcdBarrier b; b.bar = bar; b.x = xb_xcc_id(); b.st = st;
  if (threadIdx.x == 0) (void)xb_add(&bar[XB_XCNT(b.x)], 1u);
  return b;
}
DI void xcd_barrier_complete(unsigned* bar, unsigned x, unsigned& nloc, unsigned& nx) {
  const unsigned G = gridDim.x * gridDim.y * gridDim.z;
  unsigned sum, cnt, mine, sp = 0u;
  for (;;) {
    sum = 0u; cnt = 0u; mine = 0u;
#pragma unroll
    for (unsigned j = 0; j < 16; ++j) { const unsigned c = xb_ld(&bar[XB_XCNT(j)]); sum += c; cnt += (c > 0u) ? 1u : 0u; mine = (j == x) ? c : mine; }
    if (sum == G) break;
    __builtin_amdgcn_s_sleep(1);
    if ((++sp & 255u) == 0u) { if (xb_ld(&bar[XB_TMO])) break; if (sp > XB_SPIN_CAP) { atomicAdd(&bar[XB_TMO], 1u); break; } }
  }
  nloc = mine > 0u ? mine : 1u; nx = cnt > 0u ? cnt : 1u;
}
DI void xcd_barrier(const XcdBarrier& b) {
  asm volatile("s_waitcnt vmcnt(0)" ::: "memory");
  __syncthreads();
  if (threadIdx.x == 0) {
    unsigned* bar = b.bar;
    __builtin_amdgcn_s_waitcnt(0);
    unsigned nloc = b.st[0], nx = b.st[1];
    if (nloc == 0u) { xcd_barrier_complete(bar, b.x, nloc, nx); b.st[0] = nloc; b.st[1] = nx; }
    const unsigned old = xb_add(&bar[XB_XSUB(b.x)], 1u);
    const unsigned gen = old / nloc;
    if (old + 1u == (gen + 1u) * nloc) {
      __builtin_amdgcn_fence(__ATOMIC_RELEASE, "agent");
      asm volatile("s_waitcnt vmcnt(0)" ::: "memory");
      const unsigned og = xb_add(&bar[XB_TOP], 1u);
      const unsigned tg = og / nx;
      if (og + 1u == (tg + 1u) * nx) xb_add(&bar[XB_TOPGEN], 1u);
      else XB_SPIN(xb_ld(&bar[XB_TOPGEN]) == tg, bar);
      __builtin_amdgcn_fence(__ATOMIC_ACQUIRE, "agent");
      xb_add(&bar[XB_XGEN(b.x)], 1u);
      asm volatile("s_waitcnt vmcnt(0)" ::: "memory");
    } else {
      XB_SPIN(xb_ld(&bar[XB_XGEN(b.x)]) == gen, bar);
      __builtin_amdgcn_fence(__ATOMIC_ACQUIRE, "agent");
      asm volatile("s_waitcnt vmcnt(0)" ::: "memory");
    }
  }
  __syncthreads();
}

constexpr int DYN_LDS = 131072 + 64 + 12288;
__global__ void __launch_bounds__(512, 2) hybrid_megakernel(Params P) {
  extern __shared__ __attribute__((aligned(16))) unsigned char dyn[];
  cg::grid_group grid = cg::this_grid();
  volatile LAS unsigned* xbw = (volatile LAS unsigned*)((LAS unsigned char*)dyn + 131072);
  if (threadIdx.x == 0) { xbw[0] = 0u; xbw[1] = 0u; }
  __syncthreads();
  XcdBarrier xb = xcd_barrier_post((unsigned*)P.ws, xbw);
  char* smem = (char*)dyn + (threadIdx.x >> 8) * 65536;
  pg8::PG8_LAS_T* glds = (pg8::PG8_LAS_T*)dyn;
  prep_phase(P, smem);
  grid.sync();
  const __attribute__((address_space(3))) f32x2_t* ltab = (const __attribute__((address_space(3))) f32x2_t*)((LAS unsigned char*)dyn + 131072 + 64);
  {
    __attribute__((address_space(3))) f32x2_t* lt = (__attribute__((address_space(3))) f32x2_t*)((LAS unsigned char*)dyn + 131072 + 64);
    const f32x2_t* gt = (const f32x2_t*)(P.ws + OFF_ROPEA);
    for (int i = threadIdx.x; i < 1536; i += 512) lt[i] = gt[i];
    __syncthreads();
  }
  for (int l = 0; l < 2; ++l) {
    for (int g = 0; g < NGROUP; ++g) {
      norm_phase(P, l, g, 0, !(l == 0 && g == 0));
      xcd_barrier(xb);
      { EpiIn E; E.P = &P; E.l = l; E.g = g; E.ltab = ltab; gemm_run(glds, (const u16*)(P.ws + OFF_HB), (const u16*)(P.ws + OFF_WIN) + (size_t)l * 3584 * 1024, 3584, 1024, E); }
      xcd_barrier(xb);
      mix1_phase(P, l, g, smem, (char*)dyn + 65536 + (threadIdx.x >> 9) * 16);
      xcd_barrier(xb);
      scan_phase(P, l, g);
      xcd_barrier(xb);
      mix3_phase(P, l, g, smem);
      xcd_barrier(xb);
      { EpiResid<0> E; E.P = &P; E.l = l; E.g = g; gemm_run(glds, (const u16*)(P.ws + OFF_HB), (const u16*)(P.ws + OFF_WOUT) + (size_t)l * 1024 * 1024, 1024, 1024, E); }
      xcd_barrier(xb);
      norm_phase(P, l, g, 1, false);
      xcd_barrier(xb);
      { EpiSwiglu E; E.P = &P; gemm_run(glds, (const u16*)(P.ws + OFF_HB), (const u16*)(P.ws + OFF_WFI) + (size_t)l * 5632 * 1024, 5632, 1024, E); }
      xcd_barrier(xb);
      { EpiResid<1> E; E.P = &P; E.l = l; E.g = g; gemm_run(glds, (const u16*)(P.ws + OFF_PB), (const u16*)(P.ws + OFF_WFO) + (size_t)l * 1024 * 2816, 1024, 2816, E); }
      if (l == 0) prep_l1_half(P, smem, g);
    }
  }
}

extern "C" void kernel_launch(void* const* d_in, const int* in_sizes, int n_in, void* d_out, int out_size, void* d_ws, size_t ws_size,
                              hipStream_t stream) {
  static int grid_blocks = 0;
  if (!grid_blocks) {
    int dev = 0, cus = 0, per_cu = 0;
    hipGetDevice(&dev);
    hipDeviceGetAttribute(&cus, hipDeviceAttributeMultiprocessorCount, dev);
    if (hipFuncSetAttribute((const void*)hybrid_megakernel, hipFuncAttributeMaxDynamicSharedMemorySize, DYN_LDS) != hipSuccess) fprintf(stderr, "hipFuncSetAttribute failed\n");
    hipOccupancyMaxActiveBlocksPerMultiprocessor(&per_cu, (const void*)hybrid_megakernel, 512, DYN_LDS);
    if (per_cu > 1) per_cu = 1;
    if (per_cu < 1) { fprintf(stderr, "occupancy query returned %d\n", per_cu); per_cu = 1; }
    grid_blocks = cus * per_cu;
  }
  if (ws_size < WS_TOTAL) fprintf(stderr, "workspace too small: %zu < %zu\n", ws_size, (size_t)WS_TOTAL);
  Params p{};
  const float** pp = (const float**)&p;
  for (int i = 0; i < 29; ++i) pp[i] = (const float*)d_in[i];
  p.out = (float*)d_out;
  p.ws = (char*)d_ws;
  hipMemsetAsync(d_ws, 0, 16384, stream);
  void* args[] = {&p};
  hipError_t e = hipLaunchCooperativeKernel((void*)hybrid_megakernel, dim3(grid_blocks), dim3(512), args, DYN_LDS, stream);
  if (e != hipSuccess) fprintf(stderr, "cooperative launch failed: %s (grid %d)\n", hipGetErrorString(e), grid_blocks);
}
```

```cpp
#include <hip/hip_runtime.h>
#include <hip/hip_cooperative_groups.h>
#include <cstdio>
namespace cg = cooperative_groups;

typedef unsigned short u16;
typedef __attribute__((ext_vector_type(8))) short bf16x8;
typedef __attribute__((ext_vector_type(4))) short s16x4;
typedef __attribute__((ext_vector_type(4))) float f32x4;
#define DI __device__ __forceinline__
#define MFMA(a, b, c) __builtin_amdgcn_mfma_f32_16x16x32_bf16((a), (b), (c), 0, 0, 0)

constexpr int NPT = 8192;
constexpr int GT = 12288;
constexpr int NGROUP = 2;
constexpr int PW = 2176;
constexpr int NCH = GT / 64;
constexpr float EPS = 1e-6f;
constexpr float LOG2E = 1.4426950408889634f;

constexpr int PC_RQ = 0, PC_RK = 256, PC_RG = 512, PC_WQ = 768, PC_WK = 1024, PC_DQ = 1152, PC_DK = 1408, PC_HQ = 1664, PC_HG = 1920;
constexpr int VH_RET = 0, VH_WIN = 4, VH_DIFF = 6, VH_HGRN = 10;

constexpr size_t OFF_KN = 14336;
constexpr size_t OFF_MOD = 16384;
constexpr size_t OFF_ROPEA = OFF_MOD + 2 * 5 * 6144 * 4;
constexpr size_t OFF_ROPEB = OFF_ROPEA + 64 * 16 * 8;
constexpr size_t OFF_WIN = OFF_ROPEB + 64 * 8 * 8;
constexpr size_t OFF_WOUT = OFF_WIN + (size_t)2 * 3584 * 1024 * 2;
constexpr size_t OFF_WFI = OFF_WOUT + (size_t)2 * 1024 * 1024 * 2;
constexpr size_t OFF_WFO = OFF_WFI + (size_t)2 * 5632 * 1024 * 2;
constexpr size_t OFF_CWK = OFF_WFO + (size_t)2 * 1024 * 2816 * 2;
constexpr size_t OFF_CWVT = OFF_CWK + (size_t)2 * 4 * 2 * 512 * 64 * 2;
constexpr size_t OFF_CDK = OFF_CWVT + (size_t)2 * 4 * 2 * 512 * 64 * 2;
constexpr size_t OFF_CDVT = OFF_CDK + (size_t)2 * 4 * 4 * 2 * 512 * 32 * 2;
constexpr size_t OFF_HB = OFF_CDVT + (size_t)2 * 4 * 4 * 64 * 512 * 2;
constexpr size_t OFF_PB = OFF_HB + (size_t)GT * 1024 * 2;
constexpr size_t OFF_VT = OFF_PB + (size_t)GT * 2816 * 2;
constexpr size_t OFF_LF = OFF_VT + (size_t)14 * 64 * GT * 2;
constexpr size_t OFF_ST = OFF_LF + (size_t)2 * GT * 256 * 4;
constexpr size_t OFF_DEC = OFF_ST + (size_t)2 * NCH * 2 * 4 * 4096 * 4;
constexpr size_t WS_TOTAL = OFF_DEC + (size_t)2 * NCH * 2 * 4 * 64 * 4;

constexpr size_t O_SRET = 25165824, O_CWK = 27262976, O_CWV = 29360128, O_CDK = 31457280, O_CDV = 35651584, O_SHG = 39845888;

struct Params {
  const float *x_prompt, *x_sample, *state_ret, *cwk, *cwv, *cdk, *cdv, *state_hgrn, *c, *c_ctx, *norm1_g, *norm2_g, *w_ada, *b_ada,
      *w_in, *ret_decay, *ret_norm_g, *win_q_norm, *win_k_norm, *win_sink, *diff_q_norm, *diff_k_norm, *diff_lambda, *diff_norm_g,
      *hgrn_lb, *hgrn_norm_g, *w_out, *w_ffn_in, *w_ffn_out;
  float* out;
  char* ws;
};

typedef float f32x2_t __attribute__((ext_vector_type(2)));
typedef __bf16 bf16x2_t __attribute__((ext_vector_type(2)));
DI unsigned pack2(float a, float b) { f32x2_t v = {a, b}; bf16x2_t r = __builtin_convertvector(v, bf16x2_t); return __builtin_bit_cast(unsigned, r); }
DI u16 f2bf(float x) { return (u16)(pack2(x, 0.f) & 0xffffu); }
DI float bf2f(u16 h) { return __uint_as_float(((unsigned)h) << 16); }
DI float silu(float x) { return x * __builtin_amdgcn_rcpf(1.f + __builtin_amdgcn_exp2f(-1.4426950408889634f * x)); }
DI int get_tid() { int t = threadIdx.x & 255; asm volatile("" : "+v"(t)); return t; }
DI int get_vb() { int t = __builtin_amdgcn_readfirstlane((int)(blockIdx.x * 2 + (threadIdx.x >> 8))); asm volatile("" : "+s"(t)); return t; }
#define NVB ((int)gridDim.x * 2)
DI int cond_of(int gtok) { return gtok < NPT ? 0 : 1 + ((gtok - NPT) >> 12); }

template <class RM>
DI void transpose_tile(const float* __restrict__ src, size_t ld_src, u16* __restrict__ dst, size_t ld_dst, float* sm, RM rowmap) {
  const int tid = get_tid();
#pragma unroll
  for (int i = 0; i < 16; ++i) { int e = tid + 256 * i; int r = e >> 6, c = e & 63; sm[r * 65 + c] = src[(size_t)r * ld_src + c]; }
  __syncthreads();
#pragma unroll
  for (int i = 0; i < 16; ++i) { int e = tid + 256 * i; int c = e >> 6, r = e & 63; dst[(size_t)rowmap(c) * ld_dst + r] = f2bf(sm[r * 65 + c]); }
  __syncthreads();
}

struct WItem { const float* src; size_t ld_src; u16* dst; size_t ld_dst; int kind, nb; };
DI WItem weight_desc(const Params& P, int l, int r) {
  WItem w;
  if (r < 896) { const int kt = r / 56, nt = r % 56; w.src = P.w_in + (size_t)l * 1024 * 3584 + (size_t)kt * 64 * 3584 + nt * 64; w.ld_src = 3584;
                 w.dst = (u16*)(P.ws + OFF_WIN) + (size_t)l * 3584 * 1024 + kt * 64; w.ld_dst = 1024; w.kind = 1; w.nb = nt * 64; }
  else if (r < 1152) { r -= 896; const int kt = r / 16, nt = r % 16; w.src = P.w_out + (size_t)l * 1024 * 1024 + (size_t)kt * 64 * 1024 + nt * 64; w.ld_src = 1024;
                 w.dst = (u16*)(P.ws + OFF_WOUT) + (size_t)l * 1024 * 1024 + kt * 64; w.ld_dst = 1024; w.kind = 0; w.nb = nt * 64; }
  else if (r < 2560) { r -= 1152; const int kt = r / 88, nt = r % 88; w.src = P.w_ffn_in + (size_t)l * 1024 * 5632 + (size_t)kt * 64 * 5632 + nt * 64; w.ld_src = 5632;
                 w.dst = (u16*)(P.ws + OFF_WFI) + (size_t)l * 5632 * 1024 + kt * 64; w.ld_dst = 1024; w.kind = 2; w.nb = nt * 64; }
  else { r -= 2560; const int kt = r / 16, nt = r % 16; w.src = P.w_ffn_out + (size_t)l * 2816 * 1024 + (size_t)kt * 64 * 1024 + nt * 64; w.ld_src = 1024;
                 w.dst = (u16*)(P.ws + OFF_WFO) + (size_t)l * 1024 * 2816 + kt * 64; w.ld_dst = 2816; w.kind = 0; w.nb = nt * 64; }
  return w;
}
DI int weight_rowmap(int kind, int nb, int c) {
  const int cc = nb + c;
  if (kind == 1) { const int ct = cc & 255; return (cc & ~255) + 128 * ((ct >> 5) & 1) + 32 * (ct >> 6) + (ct & 31); }
  if (kind == 2) { const int sgn = cc >= 2816 ? 1 : 0; const int jn = cc - sgn * 2816; return 256 * (jn >> 7) + 128 * sgn + (jn & 127); }
  return cc;
}
DI void transpose2(const WItem& a, const WItem& b, const bool has_b, float* sm) {
  const int tid = get_tid();
  float va[16], vb[16];
#pragma unroll
  for (int i = 0; i < 16; ++i) { const int e = tid + 256 * i; const int r = e >> 6, c = e & 63; va[i] = __builtin_nontemporal_load(a.src + (size_t)r * a.ld_src + c); }
  if (has_b) {
#pragma unroll
    for (int i = 0; i < 16; ++i) { const int e = tid + 256 * i; const int r = e >> 6, c = e & 63; vb[i] = __builtin_nontemporal_load(b.src + (size_t)r * b.ld_src + c); }
  } else {
#pragma unroll
    for (int i = 0; i < 16; ++i) vb[i] = 0.f;
  }
#pragma unroll
  for (int i = 0; i < 16; ++i) { const int e = tid + 256 * i; const int r = e >> 6, c = e & 63; sm[r * 65 + c] = va[i]; sm[4160 + r * 65 + c] = vb[i]; }
  __syncthreads();
#pragma unroll
  for (int i = 0; i < 16; ++i) { const int e = tid + 256 * i; const int c = e >> 6, r = e & 63; a.dst[(size_t)weight_rowmap(a.kind, a.nb, c) * a.ld_dst + r] = f2bf(sm[r * 65 + c]); }
  if (has_b) {
#pragma unroll
    for (int i = 0; i < 16; ++i) { const int e = tid + 256 * i; const int c = e >> 6, r = e & 63; b.dst[(size_t)weight_rowmap(b.kind, b.nb, c) * b.ld_dst + r] = f2bf(sm[4160 + r * 65 + c]); }
  }
  __syncthreads();
}

DI void prep_l1_half(const Params& P, char* smem, int part) {
  constexpr int PER_L = 896 + 256 + 1408 + 704, HALFN = PER_L / 2, NUNITS = (GT / 256) * 4;
  if ((int)gridDim.x <= NUNITS || (int)blockIdx.x < NUNITS) return;
  const int vb0 = get_vb() - NUNITS * 2, nvb = NVB - NUNITS * 2;
  const int rend = (part + 1) * HALFN;
  for (int r = part * HALFN + vb0; r < rend; r += 2 * nvb) {
    const int r2 = r + nvb; const bool has_b = r2 < rend;
    const WItem wa = weight_desc(P, 1, r);
    const WItem wb = weight_desc(P, 1, has_b ? r2 : r);
    transpose2(wa, wb, has_b, (float*)smem);
  }
}

DI void prep_phase(const Params& P, char* smem) {
  float* sm = (float*)smem;
  const int tid = get_tid();
  constexpr int PER_L = 896 + 256 + 1408 + 704;
  constexpr int N_W = 2 * PER_L;
  constexpr int N_CWV = 128, N_CDV = 256, N_MOD = 192;
  constexpr int N_KN = 80;
  constexpr int TOTAL = N_W + N_CWV + N_CDV + N_MOD + N_KN + 1;
  const int n_w_now = ((int)gridDim.x > (GT / 256) * 4) ? PER_L : N_W;
  for (int it = get_vb(); it < n_w_now; it += 2 * NVB) {
    const int it2 = it + NVB; const bool has_b = it2 < n_w_now;
    const WItem wa = weight_desc(P, it / PER_L, it % PER_L);
    const WItem wb = weight_desc(P, has_b ? it2 / PER_L : it / PER_L, has_b ? it2 % PER_L : it % PER_L);
    transpose2(wa, wb, has_b, sm);
  }
  for (int it = N_W + get_vb(); it < TOTAL; it += NVB) {
    if (it < N_W) {
      int l = it / PER_L, r = it % PER_L;
      if (r < 896) {
        int kt = r / 56, nt = r % 56;
        const float* src = P.w_in + (size_t)l * 1024 * 3584 + (size_t)kt * 64 * 3584 + nt * 64;
        u16* dst = (u16*)(P.ws + OFF_WIN) + (size_t)l * 3584 * 1024 + kt * 64;
        int nb = nt * 64;
        transpose_tile(src, 3584, dst, 1024, sm, [nb](int c) { int cc = nb + c; int ct = cc & 255; return (cc & ~255) + 128 * ((ct >> 5) & 1) + 32 * (ct >> 6) + (ct & 31); });
      } else if (r < 1152) {
        r -= 896; int kt = r / 16, nt = r % 16;
        const float* src = P.w_out + (size_t)l * 1024 * 1024 + (size_t)kt * 64 * 1024 + nt * 64;
        u16* dst = (u16*)(P.ws + OFF_WOUT) + (size_t)l * 1024 * 1024 + kt * 64;
        int nb = nt * 64;
        transpose_tile(src, 1024, dst, 1024, sm, [nb](int c) { return nb + c; });
      } else if (r < 2560) {
        r -= 1152; int kt = r / 88, nt = r % 88;
        const float* src = P.w_ffn_in + (size_t)l * 1024 * 5632 + (size_t)kt * 64 * 5632 + nt * 64;
        u16* dst = (u16*)(P.ws + OFF_WFI) + (size_t)l * 5632 * 1024 + kt * 64;
        int nb = nt * 64;
        transpose_tile(src, 5632, dst, 1024, sm, [nb](int c) { int n = nb + c; int s = n >= 2816 ? 1 : 0; int jn = n - s * 2816; return 256 * (jn >> 7) + 128 * s + (jn & 127); });
      } else {
        r -= 2560; int kt = r / 16, nt = r % 16;
        const float* src = P.w_ffn_out + (size_t)l * 2816 * 1024 + (size_t)kt * 64 * 1024 + nt * 64;
        u16* dst = (u16*)(P.ws + OFF_WFO) + (size_t)l * 1024 * 2816 + kt * 64;
        int nb = nt * 64;
        transpose_tile(src, 1024, dst, 2816, sm, [nb](int c) { return nb + c; });
      }
    } else if (it < N_W + N_CWV) {
      int r = it - N_W; int mat = r >> 3, kt = r & 7;
      const float* src = P.cwv + (size_t)mat * 512 * 64 + (size_t)kt * 64 * 64;
      const int dm = (((mat >> 1) & 1) * 4 + (mat >> 2)) * 2 + (mat & 1);
      u16* dst = (u16*)(P.ws + OFF_CWVT) + (size_t)dm * 64 * 512 + kt * 64;
      transpose_tile(src, 64, dst, 512, sm, [](int c) { return c; });
    } else if (it < N_W + N_CWV + N_CDV) {
      int r = it - N_W - N_CWV; int mat = r >> 3, kt = r & 7;
      const float* src = P.cdv + (size_t)mat * 512 * 64 + (size_t)kt * 64 * 64;
      const int dm = (((mat >> 2) & 1) * 4 + (mat >> 3)) * 4 + (mat & 3);
      u16* dst = (u16*)(P.ws + OFF_CDVT) + (size_t)dm * 64 * 512 + kt * 64;
      transpose_tile(src, 64, dst, 512, sm, [](int c) { return c; });
    } else if (it < N_W + N_CWV + N_CDV + N_MOD) {
      int r = it - N_W - N_CWV - N_CDV; int l = r / 96, cb = r % 96;
      for (int e = tid; e < 5 * 1024; e += 256) { int j = e >> 10, k = e & 1023; float v = (j == 0) ? P.c_ctx[k] : P.c[(j - 1) * 1024 + k]; sm[e] = silu(v); }
      __syncthreads();
      const int w = tid >> 6, lane = tid & 63; const int col = cb * 64 + lane;
      float acc[5] = {0.f, 0.f, 0.f, 0.f, 0.f};
      const float* wp = P.w_ada + (size_t)l * 1024 * 6144 + col;
#pragma unroll 8
      for (int k = w * 256; k < w * 256 + 256; ++k) {
        float wv = wp[(size_t)k * 6144];
#pragma unroll
        for (int j = 0; j < 5; ++j) acc[j] += sm[j * 1024 + k] * wv;
      }
      float* red = sm + 5 * 1024;
#pragma unroll
      for (int j = 0; j < 5; ++j) red[(w * 5 + j) * 64 + lane] = acc[j];
      __syncthreads();
      if (w == 0) {
        float* mod = (float*)(P.ws + OFF_MOD);
#pragma unroll
        for (int j = 0; j < 5; ++j) {
          float s = red[(0 * 5 + j) * 64 + lane] + red[(1 * 5 + j) * 64 + lane] + red[(2 * 5 + j) * 64 + lane] + red[(3 * 5 + j) * 64 + lane];
          mod[(size_t)(l * 5 + j) * 6144 + col] = s + P.b_ada[l * 6144 + col];
        }
      }
      __syncthreads();
    } else if (it < N_W + N_CWV + N_CDV + N_MOD + N_KN) {
      const int mi = it - (N_W + N_CWV + N_CDV + N_MOD);
      const float* src; int dim;
      if (mi < 16) { const int l_ = mi >> 3, b_ = (mi >> 1) & 3, kv = mi & 1; src = P.cwk + (size_t)((b_ * 2 + l_) * 2 + kv) * 512 * 64; dim = 64; }
      else { const int d_ = mi - 16; const int l_ = d_ >> 5, b_ = (d_ >> 3) & 3, h_ = (d_ >> 1) & 3, c_ = d_ & 1; src = P.cdk + (size_t)(((b_ * 2 + l_) * 4 + h_) * 2 + c_) * 512 * 32; dim = 32; }
      float mxn = 0.f;
      for (int k = tid; k < 512; k += 256) {
        float ss = 0.f;
        for (int i = 0; i < dim; i += 4) { const float4 v = *(const float4*)(src + (size_t)k * dim + i); ss += v.x * v.x + v.y * v.y + v.z * v.z + v.w * v.w; }
        mxn = fmaxf(mxn, ss);
      }
#pragma unroll
      for (int o_ = 32; o_ >= 1; o_ >>= 1) mxn = fmaxf(mxn, __shfl_xor(mxn, o_));
      if ((tid & 63) == 0) sm[tid >> 6] = mxn;
      __syncthreads();
      if (tid == 0) ((float*)(P.ws + OFF_KN))[mi] = fmaxf(fmaxf(sm[0], sm[1]), fmaxf(sm[2], sm[3]));
      __syncthreads();
    } else {
      float2* ta = (float2*)(P.ws + OFF_ROPEA); float2* tb = (float2*)(P.ws + OFF_ROPEB);
      for (int e = tid; e < 64 * 16 + 64 * 8; e += 256) {
        int pos, i, half;
        if (e < 1024) { pos = e >> 4; i = e & 15; half = 16; } else { int e2 = e - 1024; pos = e2 >> 3; i = e2 & 7; half = 8; }
        const double r16 = 0.5623413251903491;
        double inv = 1.0; int n = (half == 16) ? i : 2 * i;
        for (int q = 0; q < n; ++q) inv *= r16;
        float angf = (float)pos * (float)inv;
        double ang = (double)angf;
        double nq = rint(ang * 0.6366197723675814);
        double rr = ang - nq * 1.5707963267948966;
        double r2 = rr * rr;
        double sn = rr * (1.0 - r2 / 6.0 * (1.0 - r2 / 20.0 * (1.0 - r2 / 42.0 * (1.0 - r2 / 72.0 * (1.0 - r2 / 110.0 * (1.0 - r2 / 156.0))))));
        double cs = 1.0 - r2 / 2.0 * (1.0 - r2 / 12.0 * (1.0 - r2 / 30.0 * (1.0 - r2 / 56.0 * (1.0 - r2 / 90.0 * (1.0 - r2 / 132.0 * (1.0 - r2 / 182.0))))));
        int qd = ((int)nq) & 3;
        double c_, s_;
        if (qd == 0) { c_ = cs; s_ = sn; } else if (qd == 1) { c_ = -sn; s_ = cs; } else if (qd == 2) { c_ = -cs; s_ = -sn; } else { c_ = sn; s_ = -cs; }
        float2 v = make_float2((float)c_, (float)s_);
        if (e < 1024) ta[e] = v; else tb[e - 1024] = v;
      }
    }
  }
  {
    u16* d1 = (u16*)(P.ws + OFF_CWK);
    for (size_t e = (size_t)get_vb() * 256 + tid; e < (size_t)2 * 4 * 2 * 512 * 64; e += (size_t)NVB * 256) {
      size_t inner = e & (size_t)(2 * 512 * 64 - 1); size_t lb = e / (2 * 512 * 64); int l = (int)(lb >> 2), b = (int)(lb & 3);
      d1[e] = f2bf(P.cwk[((size_t)(b * 2 + l)) * (2 * 512 * 64) + inner]);
    }
    u16* d2 = (u16*)(P.ws + OFF_CDK);
    for (size_t e = (size_t)get_vb() * 256 + tid; e < (size_t)2 * 4 * 4 * 2 * 512 * 32; e += (size_t)NVB * 256) {
      size_t inner = e & (size_t)(4 * 2 * 512 * 32 - 1); size_t lb = e / (4 * 2 * 512 * 32); int l = (int)(lb >> 2), b = (int)(lb & 3);
      d2[e] = f2bf(P.cdk[((size_t)(b * 2 + l)) * (4 * 2 * 512 * 32) + inner]);
    }
  }
}

DI void norm_phase(const Params& P, int l, int g, int which, const bool idle_only) {
  const int tid_ = get_tid(); const int lane = tid_ & 63, w = tid_ >> 6;
  const float* mod = (const float*)(P.ws + OFF_MOD);
  u16* HB = (u16*)(P.ws + OFF_HB);
  const float* gn = (which ? P.norm2_g : P.norm1_g) + l * 1024;
  int vb0 = get_vb(), nvb = NVB;
  if (idle_only) { const int nunits = (GT / 256) * 4; if ((int)gridDim.x > nunits) { if ((int)blockIdx.x < nunits) return; vb0 -= nunits * 2; nvb -= nunits * 2; } }
  const int rows_per = (GT + nvb - 1) / nvb;
  const int rbeg = vb0 * rows_per, rend = (rbeg + rows_per < GT) ? rbeg + rows_per : GT;
  float4 gg[4], s4[4], h4[4];
#pragma unroll
  for (int i = 0; i < 4; ++i) { gg[i] = *(const float4*)(gn + (i * 64 + lane) * 4); s4[i] = gg[i]; h4[i] = gg[i]; }
  int cur_cond = -1;
  auto row_src = [&](int row) -> const float* {
    const int gtok = g * GT + row;
    if (which == 0 && l == 0) return gtok < NPT ? P.x_prompt + (size_t)gtok * 1024 : P.x_sample + (size_t)(gtok - NPT) * 1024;
    return P.out + (size_t)gtok * 1024;
  };
  int row = rbeg + w;
  float4 v[4];
  if (row < rend) {
    const float* src = row_src(row);
#pragma unroll
    for (int i = 0; i < 4; ++i) v[i] = *(const float4*)(src + (i * 64 + lane) * 4);
  }
  for (; row < rend; row += 4) {
    const int gtok = g * GT + row;
    float ss = 0.f;
#pragma unroll
    for (int i = 0; i < 4; ++i) ss += v[i].x * v[i].x + v[i].y * v[i].y + v[i].z * v[i].z + v[i].w * v[i].w;
    float4 vn[4];
    if (row + 4 < rend) {
      const float* srcn = row_src(row + 4);
#pragma unroll
      for (int i = 0; i < 4; ++i) vn[i] = *(const float4*)(srcn + (i * 64 + lane) * 4);
    } else {
#pragma unroll
      for (int i = 0; i < 4; ++i) vn[i] = v[i];
    }
    const int cnd = cond_of(gtok);
    if (cnd != cur_cond) {
      cur_cond = cnd;
      const float* mrow = mod + (size_t)(l * 5 + cnd) * 6144;
      const float* sh = mrow + (which ? 3 : 0) * 1024; const float* sc = mrow + (which ? 4 : 1) * 1024;
#pragma unroll
      for (int i = 0; i < 4; ++i) { s4[i] = *(const float4*)(sc + (i * 64 + lane) * 4); h4[i] = *(const float4*)(sh + (i * 64 + lane) * 4); }
    }
#pragma unroll
    for (int o = 32; o >= 1; o >>= 1) ss += __shfl_xor(ss, o);
    const float rstd = rsqrtf(ss * (1.f / 1024.f) + EPS);
#pragma unroll
    for (int i = 0; i < 4; ++i) {
      const int col = (i * 64 + lane) * 4;
      const float a = v[i].x * rstd * gg[i].x * (1.f + s4[i].x) + h4[i].x, b = v[i].y * rstd * gg[i].y * (1.f + s4[i].y) + h4[i].y;
      const float c = v[i].z * rstd * gg[i].z * (1.f + s4[i].z) + h4[i].z, d = v[i].w * rstd * gg[i].w * (1.f + s4[i].w) + h4[i].w;
      uint2 o2; o2.x = pack2(a, b); o2.y = pack2(c, d);
      *(uint2*)(HB + (size_t)row * 1024 + col) = o2;
    }
#pragma unroll
    for (int i = 0; i < 4; ++i) v[i] = vn[i];
  }
}

namespace pg8 {
#define PG8_LAS __attribute__((address_space(3)))
typedef unsigned short bf16_t;
typedef short bf16x8 __attribute__((ext_vector_type(8)));
typedef float f32x4 __attribute__((ext_vector_type(4)));
typedef unsigned u32x4 __attribute__((ext_vector_type(4)));
typedef PG8_LAS unsigned char PG8_LAS_T;
constexpr int BM = 256, BK = 64, HALF = 128, HTB = HALF * BK * 2  , STAGE_BYTES = 8 * HTB, NXCD = 8, WGM = 6;

__host__ __device__ __forceinline__ int lds_byte(int r, int c) { const int st = (r >> 4) * 2 + (c >> 5), rr = r & 15, cc = c & 31, ob = rr * 64 + cc * 2; return st * 1024 + (ob ^ (((ob >> 9) & 1) << 5)); }
__host__ __device__ __forceinline__ void stage_rc(int b, int& R, int& C) { const int st = b / 1024, sb = b % 1024, swz = sb ^ (((sb >> 9) & 1) << 5); R = (st >> 1) * 16 + swz / 64; C = (st & 1) * 32 + (swz % 64) / 2; }
__host__ __device__ __forceinline__ int perm32(int rho) { const int n = rho >> 4, i = rho & 15; return 8 * (i >> 2) + 4 * n + (i & 3); }

struct Unit { int pm, pn; };
struct Gemm { const bf16_t* A; const bf16_t* Bt; int M, N, K; };

struct StaticOrder {
    int nM, nN, nwg, G, c;
    __host__ __device__ void init(int M, int N, int G_, int c_) { nM = M / BM; nN = N / BM; nwg = nM * nN; G = G_; c = c_; }
    __host__ __device__ bool next(int i, Unit& u) const {
        const long L = (long)i * G + c; if (L >= nwg) return false;
        int wgid = (int)L; { const int q = nwg / NXCD, r = nwg % NXCD, xcd = wgid % NXCD, off = wgid / NXCD; wgid = (xcd < r ? xcd * (q + 1) : r * (q + 1) + (xcd - r) * q) + off; }
        const int nig = WGM * nN, gid = wgid / nig, fm = gid * WGM, gsz = (nM - fm) < WGM ? (nM - fm) : WGM;
        u.pm = fm + ((wgid % nig) % gsz); u.pn = (wgid % nig) / gsz; return true;
    }
    __device__ __forceinline__ void a_ready(const Unit&) const {}
    __device__ __forceinline__ void done(const Unit&) const {}
};

template <class Epi, class Sched, bool STAMP = false>
__device__ __forceinline__ void gemm_phase(PG8_LAS unsigned char* lds, const Gemm g, const Sched& S, const Epi& E, unsigned long long* stamps) {
    int tid_l = threadIdx.x; asm volatile("" : "+v"(tid_l));
    const int tid = tid_l, wid = __builtin_amdgcn_readfirstlane(tid >> 6), lane = tid & 63, wr = wid >> 2, wc = wid & 3, fr = lane & 15, fq = lane >> 4;
    const int K = g.K, nt = K / BK;
    int ts_lo = 0, ts_hi = 0, nts = 0; const unsigned long long rt_entry = STAMP ? (unsigned long long)wall_clock64() : 0ull;
#define PG8_STAMP() do { if (STAMP && wid == 0 && nts < 64) { const unsigned long long _c = (unsigned long long)clock64(); \
        ts_lo = (lane == nts) ? (int)(unsigned)_c : ts_lo; ts_hi = (lane == nts) ? (int)(unsigned)(_c >> 32) : ts_hi; ++nts; } } while (0)
    PG8_STAMP();
    unsigned voffA[2], voffB[2];
#pragma unroll
    for (int i = 0; i < 2; ++i) { int R, C; stage_rc(tid * 16 + i * 8192, R, C); const int Rb = Epi::PERM ? ((R & ~31) + perm32(R & 31)) : R;
        voffA[i] = (unsigned)(R * K + C) * 2u; voffB[i] = (unsigned)(Rb * K + C) * 2u; }
    const size_t kstep = (size_t)(BK * 2);
    const size_t hstep = (size_t)HALF * K * 2;
    const size_t tstep = 2 * hstep;
    const unsigned ldsw = (unsigned)wid * 1024u;
    const int aoff = lds_byte(wr * 64 + fr, fq * 8), boff = lds_byte(wc * 32 + fr, fq * 8);
#define PG8_SA(b, h) (((b) * 2 + (h)) * HTB)
#define PG8_SB(b, h) ((4 + (b) * 2 + (h)) * HTB)
#define PG8_STAGE(bufoff, gbase, voff) do { _Pragma("unroll") for (int _i = 0; _i < 2; ++_i) \
        __builtin_amdgcn_global_load_lds((const unsigned*)((const char*)(gbase) + (voff)[_i]), (PG8_LAS unsigned*)(lds + (bufoff) + ldsw + _i * 8192), 16, 0, 0); } while (0)
#define PG8_LDA(dst, b, h) do { _Pragma("unroll") for (int m = 0; m < 4; ++m) _Pragma("unroll") for (int k = 0; k < 2; ++k) dst[m][k] = *(const PG8_LAS bf16x8*)(lds + PG8_SA(b, h) + aoff + m * 2048 + k * 1024); } while (0)
#define PG8_LDB(dst, b, h) do { _Pragma("unroll") for (int n = 0; n < 2; ++n) _Pragma("unroll") for (int k = 0; k < 2; ++k) dst[n][k] = *(const PG8_LAS bf16x8*)(lds + PG8_SB(b, h) + boff + n * 2048 + k * 1024); } while (0)
#define PG8_MMA(ai, bj, At, Bt) do { __builtin_amdgcn_s_setprio(1); _Pragma("unroll") for (int m = 0; m < 4; ++m) _Pragma("unroll") for (int n = 0; n < 2; ++n) _Pragma("unroll") for (int k = 0; k < 2; ++k) \
        acc[ai][bj][m][n] = __builtin_amdgcn_mfma_f32_16x16x32_bf16(Bt[n][k], At[m][k], acc[ai][bj][m][n], 0, 0, 0); __builtin_amdgcn_s_setprio(0); } while (0)
#define PG8_WAIT_V(n) asm volatile("s_waitcnt vmcnt(" #n ")" ::: "memory")
#define PG8_WAIT_L(n) asm volatile("s_waitcnt lgkmcnt(" #n ")" ::: "memory")
#define PG8_BAR __builtin_amdgcn_s_barrier()
#define PG8_SCHED __builtin_amdgcn_sched_barrier(0)
    Unit cur, nxt; int ui = 0;
    if (!S.next(0, cur)) return;
    f32x4 acc[2][2][4][2];
#pragma unroll
    for (int a = 0; a < 2; ++a)
#pragma unroll
        for (int b = 0; b < 2; ++b)
#pragma unroll
            for (int m = 0; m < 4; ++m)
#pragma unroll
                for (int n = 0; n < 2; ++n) acc[a][b][m][n] = (f32x4){0.f, 0.f, 0.f, 0.f};
    bf16x8 At[4][2], B0[2][2], B1[2][2];
    const char* cA = (const char*)g.A + (size_t)cur.pm * tstep; const char* cB = (const char*)g.Bt + (size_t)cur.pn * tstep;
    S.a_ready(cur);
    PG8_STAGE(PG8_SB(0, 0), cB, voffB); PG8_STAGE(PG8_SA(0, 0), cA, voffA); PG8_STAGE(PG8_SB(0, 1), cB + hstep, voffB); PG8_STAGE(PG8_SA(0, 1), cA + hstep, voffA);
    if (wr == 1) PG8_BAR;
    PG8_WAIT_V(4); PG8_BAR;
    PG8_STAGE(PG8_SB(1, 0), cB + kstep, voffB); PG8_STAGE(PG8_SA(1, 0), cA + kstep, voffA); PG8_STAGE(PG8_SB(1, 1), cB + hstep + kstep, voffB);
    PG8_WAIT_V(6); PG8_BAR;
    PG8_STAMP();
    for (;;) {
        const bool has_next = S.next(ui + 1, nxt);
        const char* nA = has_next ? (const char*)g.A + (size_t)nxt.pm * tstep : cA; const char* nB = has_next ? (const char*)g.Bt + (size_t)nxt.pn * tstep : cB;
        for (int t = 0; t < nt; t += 2) {
            const bool last = (t == nt - 2);
            const char* a1 = cA + (size_t)(t + 1) * kstep;
            const char* a2 = last ? nA : cA + (size_t)(t + 2) * kstep; const char* b2 = last ? nB : cB + (size_t)(t + 2) * kstep;
            const char* a3 = a2 + kstep; const char* b3 = b2 + kstep;
            if (last && has_next) S.a_ready(nxt);
            PG8_LDB(B0, 0, 0); PG8_SCHED; PG8_LDA(At, 0, 0); PG8_STAGE(PG8_SA(1, 1), a1 + hstep, voffA);
            PG8_WAIT_L(8); PG8_BAR; PG8_WAIT_L(0); PG8_MMA(0, 0, At, B0); PG8_BAR; PG8_SCHED;
            PG8_LDB(B1, 0, 1); PG8_STAGE(PG8_SB(0, 0), b2, voffB);
            PG8_BAR; PG8_WAIT_L(0); PG8_MMA(0, 1, At, B1); PG8_BAR;
            PG8_LDA(At, 0, 1); PG8_STAGE(PG8_SA(0, 0), a2, voffA);
            PG8_BAR; PG8_WAIT_L(0); PG8_MMA(1, 0, At, B0); PG8_BAR; PG8_SCHED;
            PG8_STAGE(PG8_SB(0, 1), b2 + hstep, voffB);
            PG8_WAIT_V(6); PG8_BAR; PG8_MMA(1, 1, At, B1); PG8_BAR;
            PG8_LDB(B0, 1, 0); PG8_SCHED; PG8_LDA(At, 1, 0); PG8_STAGE(PG8_SA(0, 1), a2 + hstep, voffA);
            PG8_WAIT_L(8); PG8_BAR; PG8_WAIT_L(0); PG8_MMA(0, 0, At, B0); PG8_BAR; PG8_SCHED;
            PG8_LDB(B1, 1, 1); PG8_STAGE(PG8_SB(1, 0), b3, voffB);
            PG8_BAR; PG8_WAIT_L(0); PG8_MMA(0, 1, At, B1); PG8_BAR;
            PG8_LDA(At, 1, 1); PG8_STAGE(PG8_SA(1, 0), a3, voffA);
            PG8_BAR; PG8_WAIT_L(0); PG8_MMA(1, 0, At, B0); PG8_BAR; PG8_SCHED;
            PG8_STAGE(PG8_SB(1, 1), b3 + hstep, voffB);
            PG8_WAIT_V(6); PG8_BAR; PG8_MMA(1, 1, At, B1); PG8_BAR;
        }
        PG8_STAMP();
        if constexpr (!Epi::AFTER_DRAIN) { E(acc, cur, wr, wc, fr, fq); S.done(cur); }
        PG8_STAMP();
        if (!has_next) break;
#pragma unroll
        for (int a = 0; a < 2; ++a)
#pragma unroll
            for (int b = 0; b < 2; ++b)
#pragma unroll
                for (int m = 0; m < 4; ++m)
#pragma unroll
                    for (int n = 0; n < 2; ++n) acc[a][b][m][n] = (f32x4){0.f, 0.f, 0.f, 0.f};
        cur = nxt; cA = nA; cB = nB; ++ui;
    }
    PG8_WAIT_V(0);
    if (wr == 0) PG8_BAR;
    PG8_BAR;
    if constexpr (Epi::AFTER_DRAIN) { E.fused(acc, cur, wr, wc, fr, fq, lds, wid, lane); S.done(cur); }
    PG8_STAMP();
    if (STAMP && wid == 0) { stamps[lane] = lane < nts ? (((unsigned long long)(unsigned)ts_hi << 32) | (unsigned)ts_lo) : 0ull;
        if (lane == 62) stamps[62] = rt_entry; if (lane == 63) stamps[63] = (unsigned long long)wall_clock64(); }
#undef PG8_STAMP
#undef PG8_SA
#undef PG8_SB
#undef PG8_STAGE
#undef PG8_LDA
#undef PG8_LDB
#undef PG8_MMA
#undef PG8_WAIT_V
#undef PG8_WAIT_L
#undef PG8_BAR
#undef PG8_SCHED
}
}


using pg8::Unit;
DI void st4bf(u16* p, float a, float b, float c, float d) { uint2 v; v.x = pack2(a, b); v.y = pack2(c, d); *(uint2*)p = v; }

template <int WHICH> struct EpiResid {
  static constexpr bool PERM = false, AFTER_DRAIN = false;
  const Params* P; int l, g;
  DI const float* xrow(int gtok) const {
    if (WHICH == 0 && l == 0) return gtok < NPT ? P->x_prompt + (size_t)gtok * 1024 : P->x_sample + (size_t)(gtok - NPT) * 1024;
    return P->out + (size_t)gtok * 1024;
  }
  template <int S> DI void loadx(f32x4 (&xv)[2][2], int gtok0, int wr, int fr, int col0) const {
    const float* xin = xrow(gtok0 + (S >> 2) * 128 + wr * 64 + (S & 3) * 16 + fr);
#pragma unroll
    for (int bj = 0; bj < 2; ++bj)
#pragma unroll
      for (int n = 0; n < 2; ++n) xv[bj][n] = *(const f32x4*)(xin + col0 + bj * 128 + n * 16);
  }
  template <int S> DI void storex(const f32x4 (&acc)[2][2][4][2], const f32x4 (&xv)[2][2], const f32x4 (&gv)[2][2], int gtok0, int wr, int fr, int col0) const {
    float* xo = P->out + (size_t)(gtok0 + (S >> 2) * 128 + wr * 64 + (S & 3) * 16 + fr) * 1024;
#pragma unroll
    for (int bj = 0; bj < 2; ++bj)
#pragma unroll
      for (int n = 0; n < 2; ++n) *(f32x4*)(xo + col0 + bj * 128 + n * 16) = xv[bj][n] + gv[bj][n] * acc[S >> 2][bj][S & 3][n];
  }
  DI void operator()(const f32x4 (&acc)[2][2][4][2], const Unit& u, int wr, int wc, int fr, int fq) const {
    const int gtok0 = g * GT + u.pm * 256;
    const float* gate = (const float*)(P->ws + OFF_MOD) + (size_t)(l * 5 + cond_of(gtok0)) * 6144 + (WHICH == 0 ? 2 : 5) * 1024;
    const int col0 = u.pn * 256 + wc * 32 + 4 * fq;
    f32x4 gv[2][2], xa[2][2], xb[2][2];
#pragma unroll
    for (int bj = 0; bj < 2; ++bj)
#pragma unroll
      for (int n = 0; n < 2; ++n) gv[bj][n] = *(const f32x4*)(gate + col0 + bj * 128 + n * 16);
    loadx<0>(xa, gtok0, wr, fr, col0);
    loadx<1>(xb, gtok0, wr, fr, col0); storex<0>(acc, xa, gv, gtok0, wr, fr, col0);
    loadx<2>(xa, gtok0, wr, fr, col0); storex<1>(acc, xb, gv, gtok0, wr, fr, col0);
    loadx<3>(xb, gtok0, wr, fr, col0); storex<2>(acc, xa, gv, gtok0, wr, fr, col0);
    loadx<4>(xa, gtok0, wr, fr, col0); storex<3>(acc, xb, gv, gtok0, wr, fr, col0);
    loadx<5>(xb, gtok0, wr, fr, col0); storex<4>(acc, xa, gv, gtok0, wr, fr, col0);
    loadx<6>(xa, gtok0, wr, fr, col0); storex<5>(acc, xb, gv, gtok0, wr, fr, col0);
    loadx<7>(xb, gtok0, wr, fr, col0); storex<6>(acc, xa, gv, gtok0, wr, fr, col0);
    storex<7>(acc, xb, gv, gtok0, wr, fr, col0);
  }
};

struct EpiSwiglu {
  static constexpr bool PERM = true, AFTER_DRAIN = false;
  const Params* P;
  DI void operator()(const f32x4 (&acc)[2][2][4][2], const Unit& u, int wr, int wc, int fr, int fq) const {
    u16* ACT = (u16*)(P->ws + OFF_PB);
#pragma unroll
    for (int ai = 0; ai < 2; ++ai)
#pragma unroll
      for (int m = 0; m < 4; ++m) {
        const int ltok = u.pm * 256 + ai * 128 + wr * 64 + m * 16 + fr;
        const f32x4 g0 = acc[ai][0][m][0], g1 = acc[ai][0][m][1], u0 = acc[ai][1][m][0], u1 = acc[ai][1][m][1];
        uint4 o4;
        o4.x = pack2(silu(g0[0]) * u0[0], silu(g0[1]) * u0[1]); o4.y = pack2(silu(g0[2]) * u0[2], silu(g0[3]) * u0[3]);
        o4.z = pack2(silu(g1[0]) * u1[0], silu(g1[1]) * u1[1]); o4.w = pack2(silu(g1[2]) * u1[2], silu(g1[3]) * u1[3]);
        *(uint4*)(ACT + (size_t)ltok * 2816 + u.pn * 128 + wc * 32 + 8 * fq) = o4;
      }
  }
};

struct EpiIn {
  static constexpr bool PERM = false, AFTER_DRAIN = false;
  const Params* P; int l, g;
  const __attribute__((address_space(3))) f32x2_t* ltab;
  DI void rope64(float (&x)[2][2][4], int ts, int fq) const {
    const __attribute__((address_space(3))) f32x2_t* ta = ltab;
#pragma unroll
    for (int bj = 0; bj < 2; ++bj) {
      const int pos = bj ? (ts & 63) : (ts >> 6);
#pragma unroll
      for (int j = 0; j < 4; ++j) { const f32x2_t cs = ta[pos * 16 + 4 * fq + j]; const float a = x[bj][0][j], b = x[bj][1][j]; x[bj][0][j] = a * cs.x - b * cs.y; x[bj][1][j] = b * cs.x + a * cs.y; }
    }
  }
  DI void rope32(float (&x)[2][2][4], int ts, int fq) const {
    const __attribute__((address_space(3))) f32x2_t* tb = ltab + 1024;
#pragma unroll
    for (int bj = 0; bj < 2; ++bj)
#pragma unroll
      for (int n = 0; n < 2; ++n) {
        const int pos = n ? (ts & 63) : (ts >> 6);
#pragma unroll
        for (int j = 0; j < 4; ++j) {
          const float v = x[bj][n][j]; const float p = __shfl_xor(v, 32);
          const f32x2_t cs = tb[pos * 8 + 4 * (fq & 1) + j];
          x[bj][n][j] = (fq < 2) ? (v * cs.x - p * cs.y) : (v * cs.x + p * cs.y);
        }
      }
  }
  DI void storeP(const float (&x)[2][2][4], int ltok, int pcol, int fq) const {
    u16* Pb = (u16*)(P->ws + OFF_PB) + (size_t)ltok * PW + pcol + 4 * fq;
#pragma unroll
    for (int bj = 0; bj < 2; ++bj)
#pragma unroll
      for (int n = 0; n < 2; ++n) st4bf(Pb + 32 * bj + 16 * n, x[bj][n][0], x[bj][n][1], x[bj][n][2], x[bj][n][3]);
  }
  DI void storeVT(const float (&x)[2][2][4], int ltok, int vhead, int fq) const {
    const int k = ltok & 3;
    u16* VT = (u16*)(P->ws + OFF_VT) + (size_t)(vhead * 64 + 4 * fq + k) * GT + (ltok & ~3);
#pragma unroll
    for (int bj = 0; bj < 2; ++bj)
#pragma unroll
      for (int n = 0; n < 2; ++n) {
        const float v0 = x[bj][n][0], v1 = x[bj][n][1], v2 = x[bj][n][2], v3 = x[bj][n][3];
        const float s01 = __shfl_xor((k & 1) ? v0 : v1, 1), s23 = __shfl_xor((k & 1) ? v2 : v3, 1);
        const float w0 = (k & 1) ? s01 : v0, w1 = (k & 1) ? v1 : s01, w2 = (k & 1) ? s23 : v2, w3 = (k & 1) ? v3 : s23;
        const float r0 = __shfl_xor((k & 2) ? w0 : w2, 2), r1 = __shfl_xor((k & 2) ? w1 : w3, 2);
        const float t0 = (k & 2) ? r0 : w0, t1 = (k & 2) ? r1 : w1, t2 = (k & 2) ? w2 : r0, t3 = (k & 2) ? w3 : r1;
        st4bf(VT + (size_t)(32 * bj + 16 * n) * GT, t0, t1, t2, t3);
      }
  }
  DI void storeF_nt(const float (&x)[2][2][4], float* dst, int fq) const {
#pragma unroll
    for (int bj = 0; bj < 2; ++bj)
#pragma unroll
      for (int n = 0; n < 2; ++n) { const f32x4 v = (f32x4){x[bj][n][0], x[bj][n][1], x[bj][n][2], x[bj][n][3]}; __builtin_nontemporal_store(v, (f32x4*)(dst + 32 * bj + 16 * n + 4 * fq)); }
  }
  DI void storeF(const float (&x)[2][2][4], float* dst, int fq) const {
#pragma unroll
    for (int bj = 0; bj < 2; ++bj)
#pragma unroll
      for (int n = 0; n < 2; ++n) *(float4*)(dst + 32 * bj + 16 * n + 4 * fq) = make_float4(x[bj][n][0], x[bj][n][1], x[bj][n][2], x[bj][n][3]);
  }
  DI void operator()(const f32x4 (&acc)[2][2][4][2], const Unit& u, int wr, int wc, int fr, int fq) const {
    const int hc = u.pn * 256 + wc * 64;
    const int gtok0 = g * GT + u.pm * 256;
    const bool samp = gtok0 >= NPT;
    float lbv[2][2][4];
#pragma unroll
    for (int bj = 0; bj < 2; ++bj)
#pragma unroll
      for (int n = 0; n < 2; ++n)
#pragma unroll
        for (int j = 0; j < 4; ++j) lbv[bj][n][j] = 0.f;
    if (l == 1 && hc >= 2560 && hc < 3072) {
      const int dir = hc >= 2816 ? 1 : 0; const int c0 = hc - (dir ? 2816 : 2560);
#pragma unroll
      for (int bj = 0; bj < 2; ++bj)
#pragma unroll
        for (int n = 0; n < 2; ++n)
#pragma unroll
          for (int j = 0; j < 4; ++j) {
            const int ch = c0 + 32 * bj + 16 * n + 4 * fq + j;
            const float a0 = P->hgrn_lb[(0 * 2 + dir) * 256 + ch], a1 = P->hgrn_lb[(1 * 2 + dir) * 256 + ch];
            lbv[bj][n][j] = __builtin_amdgcn_rcpf(1.f + __expf(a1 - a0));
          }
    }
    slot<0, 0>(acc, u, wr, fr, fq, hc, samp, lbv); slot<0, 1>(acc, u, wr, fr, fq, hc, samp, lbv); slot<0, 2>(acc, u, wr, fr, fq, hc, samp, lbv); slot<0, 3>(acc, u, wr, fr, fq, hc, samp, lbv);
    slot<1, 0>(acc, u, wr, fr, fq, hc, samp, lbv); slot<1, 1>(acc, u, wr, fr, fq, hc, samp, lbv); slot<1, 2>(acc, u, wr, fr, fq, hc, samp, lbv); slot<1, 3>(acc, u, wr, fr, fq, hc, samp, lbv);
  }
  template <int ai, int m>
  DI void slot(const f32x4 (&acc)[2][2][4][2], const Unit& u, int wr, int fr, int fq, int hc, bool samp, const float (&lbv)[2][2][4]) const {
      {
        const int ltok = u.pm * 256 + ai * 128 + wr * 64 + m * 16 + fr;
        const int gtok = g * GT + ltok;
        const int ts = (gtok - NPT) & 4095, pb = gtok >> 8, pt = gtok & 255;
        float x[2][2][4];
#pragma unroll
        for (int bj = 0; bj < 2; ++bj)
#pragma unroll
          for (int n = 0; n < 2; ++n)
#pragma unroll
            for (int j = 0; j < 4; ++j) x[bj][n][j] = acc[ai][bj][m][n][j];
        if (hc < 256) {
          if (samp) rope64(x, ts, fq);
          storeP(x, ltok, PC_RQ + hc, fq);
        } else if (hc < 512) {
#pragma unroll
          for (int bj = 0; bj < 2; ++bj)
#pragma unroll
            for (int n = 0; n < 2; ++n)
#pragma unroll
              for (int j = 0; j < 4; ++j) x[bj][n][j] *= 0.125f;
          if (samp) rope64(x, ts, fq);
          storeP(x, ltok, PC_RK + hc - 256, fq);
        } else if (hc < 768) {
          storeVT(x, ltok, VH_RET + ((hc - 512) >> 6), fq);
        } else if (hc < 1024 || hc >= 3328) {
#pragma unroll
          for (int bj = 0; bj < 2; ++bj)
#pragma unroll
            for (int n = 0; n < 2; ++n)
#pragma unroll
              for (int j = 0; j < 4; ++j) x[bj][n][j] = silu(x[bj][n][j]);
          storeP(x, ltok, hc < 1024 ? PC_RG + hc - 768 : PC_HG + hc - 3328, fq);
        } else if (hc < 1408) {
          const bool isq = hc < 1280;
          float ss = 0.f;
#pragma unroll
          for (int bj = 0; bj < 2; ++bj)
#pragma unroll
            for (int n = 0; n < 2; ++n)
#pragma unroll
              for (int j = 0; j < 4; ++j) ss += x[bj][n][j] * x[bj][n][j];
          ss += __shfl_xor(ss, 16); ss += __shfl_xor(ss, 32);
          const float rstd = rsqrtf(ss * (1.f / 64.f) + EPS);
          const float* gn = (isq ? P->win_q_norm : P->win_k_norm) + l * 64 + 4 * fq;
#pragma unroll
          for (int bj = 0; bj < 2; ++bj)
#pragma unroll
            for (int n = 0; n < 2; ++n) { const float4 g4 = *(const float4*)(gn + 32 * bj + 16 * n); x[bj][n][0] *= rstd * g4.x; x[bj][n][1] *= rstd * g4.y; x[bj][n][2] *= rstd * g4.z; x[bj][n][3] *= rstd * g4.w; }
          if (isq) {
#pragma unroll
            for (int bj = 0; bj < 2; ++bj)
#pragma unroll
              for (int n = 0; n < 2; ++n)
#pragma unroll
                for (int j = 0; j < 4; ++j) x[bj][n][j] *= 0.125f * LOG2E;
            if (samp) rope64(x, ts, fq); storeP(x, ltok, PC_WQ + hc - 1024, fq); }
          else {
            const int kvh = (hc - 1280) >> 6;
            if (!samp) storeF_nt(x, P->out + O_CWK + ((size_t)((pb * 2 + l) * 2 + kvh) * 256 + pt) * 64, fq);
            else rope64(x, ts, fq);
            storeP(x, ltok, PC_WK + hc - 1280, fq);
          }
        } else if (hc < 1536) {
          const int kvh = (hc - 1408) >> 6;
          if (!samp) storeF_nt(x, P->out + O_CWV + ((size_t)((pb * 2 + l) * 2 + kvh) * 256 + pt) * 64, fq);
          storeVT(x, ltok, VH_WIN + kvh, fq);
        } else if (hc < 2048) {
          const bool isq = hc < 1792;
          const float* gn = (isq ? P->diff_q_norm : P->diff_k_norm) + l * 32 + 4 * fq;
#pragma unroll
          for (int bj = 0; bj < 2; ++bj) {
            float ss = 0.f;
#pragma unroll
            for (int n = 0; n < 2; ++n)
#pragma unroll
              for (int j = 0; j < 4; ++j) ss += x[bj][n][j] * x[bj][n][j];
            ss += __shfl_xor(ss, 16); ss += __shfl_xor(ss, 32);
            const float rstd = rsqrtf(ss * (1.f / 32.f) + EPS);
#pragma unroll
            for (int n = 0; n < 2; ++n) { const float4 g4 = *(const float4*)(gn + 16 * n); x[bj][n][0] *= rstd * g4.x; x[bj][n][1] *= rstd * g4.y; x[bj][n][2] *= rstd * g4.z; x[bj][n][3] *= rstd * g4.w; }
          }
          if (isq) {
#pragma unroll
            for (int bj = 0; bj < 2; ++bj)
#pragma unroll
              for (int n = 0; n < 2; ++n)
#pragma unroll
                for (int j = 0; j < 4; ++j) x[bj][n][j] *= 0.17677669529663687f * LOG2E;
            if (samp) rope32(x, ts, fq); storeP(x, ltok, PC_DQ + hc - 1536, fq); }
          else {
            const int h = (hc - 1792) >> 6;
            if (!samp) {
#pragma unroll
              for (int bj = 0; bj < 2; ++bj)
#pragma unroll
                for (int n = 0; n < 2; ++n)
                  *(float4*)(P->out + O_CDK + ((size_t)(((pb * 2 + l) * 4 + h) * 2 + bj) * 256 + pt) * 32 + 16 * n + 4 * fq) = make_float4(x[bj][n][0], x[bj][n][1], x[bj][n][2], x[bj][n][3]);
            } else rope32(x, ts, fq);
            storeP(x, ltok, PC_DK + hc - 1792, fq);
          }
        } else if (hc < 2304) {
          const int h = (hc - 2048) >> 6;
          if (!samp) storeF_nt(x, P->out + O_CDV + ((size_t)((pb * 2 + l) * 4 + h) * 256 + pt) * 64, fq);
          storeVT(x, ltok, VH_DIFF + h, fq);
        } else if (hc < 2560) {
          storeP(x, ltok, PC_HQ + hc - 2304, fq);
        } else if (hc < 3072) {
          const int dir = hc >= 2816 ? 1 : 0; const int c0 = hc - (dir ? 2816 : 2560);
#pragma unroll
          for (int bj = 0; bj < 2; ++bj)
#pragma unroll
            for (int n = 0; n < 2; ++n)
#pragma unroll
              for (int j = 0; j < 4; ++j) {
                const float lb = lbv[bj][n][j];
                const float sg = __builtin_amdgcn_rcpf(1.f + __builtin_amdgcn_exp2f(-1.4426950408889634f * x[bj][n][j]));
                x[bj][n][j] = __logf(fmaxf(lb + (1.f - lb) * sg, 1e-30f));
              }
          storeF(x, (float*)(P->ws + OFF_LF) + ((size_t)dir * GT + ltok) * 256 + c0, fq);
        } else {
          storeVT(x, ltok, VH_HGRN + ((hc - 3072) >> 6), fq);
        }
      }
  }
};

template <class Epi>
DI void gemm_run(pg8::PG8_LAS_T* lds, const u16* A, const u16* Bt, int N, int K, const Epi& E) {
  pg8::Gemm gm; gm.A = A; gm.Bt = Bt; gm.M = GT; gm.N = N; gm.K = K;
  pg8::StaticOrder S; S.init(GT, N, (int)gridDim.x, (int)blockIdx.x);
  pg8::gemm_phase<Epi, pg8::StaticOrder, false>(lds, gm, S, E, nullptr);
}
DI float max3f(float a, float b, float c) { return fmaxf(fmaxf(a, b), c); }
template <int MODE>
DI void attn_compute(const char* kb, const char* vb, const bf16x8 (&qf)[2][2], f32x4 (&o)[4][2], const float mfix, f32x4 (&osum)[2],
                     const float scl, const bool domask, const int tkbase, const int tqbase, const int comp, const int fr, const int fq) {
    f32x4 s[4][2];
    const f32x4 negm = (f32x4){-mfix, -mfix, -mfix, -mfix};
    __builtin_amdgcn_s_setprio(1);
#pragma unroll
    for (int kt = 0; kt < 4; ++kt) {
      if (MODE == 0) {
        bf16x8 a0 = *(const bf16x8*)(kb + (kt * 16 + fr) * 128 + (((0 * 4 + fq) ^ (fr & 7)) * 16));
        bf16x8 a1 = *(const bf16x8*)(kb + (kt * 16 + fr) * 128 + (((1 * 4 + fq) ^ (fr & 7)) * 16));
        s[kt][0] = MFMA(a0, qf[0][0], negm); s[kt][1] = MFMA(a0, qf[1][0], negm);
        s[kt][0] = MFMA(a1, qf[0][1], s[kt][0]); s[kt][1] = MFMA(a1, qf[1][1], s[kt][1]);
      } else {
        bf16x8 a = *(const bf16x8*)(kb + (kt * 16 + fr) * 128 + (((comp * 4 + fq) ^ (fr & 7)) * 16));
        s[kt][0] = MFMA(a, qf[0][0], negm); s[kt][1] = MFMA(a, qf[1][0], negm);
      }
    }
    __builtin_amdgcn_s_setprio(0);
    bf16x8 pb[2][2];
    union { bf16x8 v; unsigned u[4]; } onesu; onesu.u[0] = onesu.u[1] = onesu.u[2] = onesu.u[3] = 0x3f803f80u;
    if (domask) {
#pragma unroll
      for (int qt = 0; qt < 2; ++qt)
#pragma unroll
        for (int kt = 0; kt < 4; ++kt)
#pragma unroll
          for (int r = 0; r < 4; ++r) { int tk = tkbase + kt * 16 + r; int tq = tqbase + qt * 16; int d = tq - tk; if (d > 128 || d < -128) s[kt][qt][r] = -1e30f; }
    }
#pragma unroll
    for (int qt = 0; qt < 2; ++qt) {
#pragma unroll
      for (int kt = 0; kt < 4; ++kt)
#pragma unroll
        for (int r = 0; r < 4; ++r) s[kt][qt][r] = __builtin_amdgcn_exp2f(s[kt][qt][r]);
#pragma unroll
      for (int kk = 0; kk < 2; ++kk) {
        union { bf16x8 v; unsigned u[4]; } pk;
        pk.u[0] = pack2(s[2 * kk][qt][0], s[2 * kk][qt][1]); pk.u[1] = pack2(s[2 * kk][qt][2], s[2 * kk][qt][3]);
        pk.u[2] = pack2(s[2 * kk + 1][qt][0], s[2 * kk + 1][qt][1]); pk.u[3] = pack2(s[2 * kk + 1][qt][2], s[2 * kk + 1][qt][3]);
        pb[qt][kk] = pk.v;
        osum[qt] = MFMA(onesu.v, pk.v, osum[qt]);
      }
    }
    __builtin_amdgcn_s_setprio(1);
#pragma unroll
    for (int kk = 0; kk < 2; ++kk)
#pragma unroll
      for (int mt = 0; mt < 4; ++mt) {
        const int voff = (mt * 16 + fr) * 128 + (((kk * 4 + (fq >> 1)) ^ (fr >> 1)) * 16) + (fq & 1) * 8;
        s16x4 lo = *(const s16x4*)(vb + voff);
        s16x4 hi = *(const s16x4*)(vb + (voff ^ 32));
        bf16x8 a = __builtin_shufflevector(lo, hi, 0, 1, 2, 3, 4, 5, 6, 7);
        o[mt][0] = MFMA(a, pb[0][kk], o[mt][0]); o[mt][1] = MFMA(a, pb[1][kk], o[mt][1]);
      }
    __builtin_amdgcn_s_setprio(0);
}

template <int MODE>
DI void attn_item(const Params& P, int l, int g, int item, char* smem, char* smem1) {
  const int tid = get_tid(), lane = tid & 63, w = tid >> 6, fr = lane & 15, fq = lane >> 4;
  int hv_ = (int)(threadIdx.x >> 8); asm volatile("" : "+v"(hv_)); const int half = __builtin_amdgcn_readfirstlane(hv_);
  const u16* Pb = (const u16*)(P.ws + OFF_PB);
  const u16* VT = (const u16*)(P.ws + OFF_VT);
  u16* MIX = (u16*)(P.ws + OFF_HB);
  int sc, h, qb;
  if (MODE == 0) { sc = ((item >> 7) + 2) % 3; int r = item & 127; h = r & 3; qb = r >> 2; } else { sc = ((item >> 8) + 2) % 3; int r = item & 255; h = r & 3; qb = r >> 2; }
  const int gsc = g * 3 + sc; const bool samp = gsc >= 2; const int b = gsc - 2;
  const int QB = (MODE == 0) ? 128 : 64;
  const int ltq0 = sc * 4096 + qb * QB;
  int t0, kstart_l, nloc, nctx, kstart_t;
  if (samp) {
    t0 = qb * QB;
    if (MODE == 0) { kstart_t = t0 - 128 < 0 ? 0 : t0 - 128; int kend = t0 + 256 > 4096 ? 4096 : t0 + 256; nloc = (kend - kstart_t) >> 6; }
    else { kstart_t = 0; nloc = 64; }
    nctx = 8; kstart_l = sc * 4096 + kstart_t;
  } else { t0 = ltq0 & 255; kstart_t = 0; kstart_l = ltq0 & ~255; nloc = 4; nctx = 0; }
  const int ntile = nloc + nctx;
  const int kvhead = (MODE == 0) ? (VH_WIN + (h >> 1)) : (VH_DIFF + h);
  const int kcol = (MODE == 0) ? (PC_WK + (h >> 1) * 64) : (PC_DK + h * 64);
  const u16* ctxK; const u16* ctxV;
  if (MODE == 0) { ctxK = (const u16*)(P.ws + OFF_CWK) + (size_t)((l * 4 + b) * 2 + (h >> 1)) * 512 * 64; ctxV = (const u16*)(P.ws + OFF_CWVT) + (size_t)((l * 4 + b) * 2 + (h >> 1)) * 64 * 512; }
  else { ctxK = (const u16*)(P.ws + OFF_CDK) + (size_t)((l * 4 + b) * 4 + h) * 2 * 512 * 32; ctxV = (const u16*)(P.ws + OFF_CDVT) + (size_t)((l * 4 + b) * 4 + h) * 64 * 512; }
  const int comp = (MODE == 1) ? (w & 1) : 0;
  const int qoff = (MODE == 0) ? 32 * w : 32 * (w >> 1);
  bf16x8 qf[2][2];
#pragma unroll
  for (int qt = 0; qt < 2; ++qt) {
    const u16* qp = Pb + (size_t)(ltq0 + qoff + qt * 16 + fr) * PW;
    if (MODE == 0) { qf[qt][0] = *(const bf16x8*)(qp + PC_WQ + h * 64 + fq * 8); qf[qt][1] = *(const bf16x8*)(qp + PC_WQ + h * 64 + 32 + fq * 8); }
    else { qf[qt][0] = *(const bf16x8*)(qp + PC_DQ + h * 64 + comp * 32 + fq * 8); qf[qt][1] = qf[qt][0]; }
  }
  const float scl = (MODE == 0 ? 0.125f : 0.17677669529663687f) * LOG2E;
  float mfix;
  {
    float gq = 0.f, gk = 0.f;
    if (MODE == 0) { for (int i = 0; i < 64; ++i) { gq = fmaxf(gq, fabsf(P.win_q_norm[l * 64 + i])); gk = fmaxf(gk, fabsf(P.win_k_norm[l * 64 + i])); } }
    else { for (int i = 0; i < 32; ++i) { gq = fmaxf(gq, fabsf(P.diff_q_norm[l * 32 + i])); gk = fmaxf(gk, fabsf(P.diff_k_norm[l * 32 + i])); } }
    const float dn = (MODE == 0) ? 8.f : 5.656854249492381f;
    float kn = dn * gk;
    if (samp) { const float* KN = (const float*)(P.ws + OFF_KN); const float k2 = (MODE == 0) ? KN[(l * 4 + b) * 2 + (h >> 1)] : KN[16 + ((l * 4 + b) * 4 + h) * 2 + comp]; kn = fmaxf(kn, sqrtf(k2)); }
    mfix = scl * dn * gq * kn;
  }
  f32x4 osum[2];
  if (MODE == 0 && half == 0) { const float ps = __builtin_amdgcn_exp2f(P.win_sink[l * 4 + h] * LOG2E - mfix); osum[0] = osum[1] = (f32x4){ps, ps, ps, ps}; }
  else { osum[0] = osum[1] = (f32x4){0.f, 0.f, 0.f, 0.f}; }
  f32x4 o[4][2];
#pragma unroll
  for (int i = 0; i < 4; ++i) { o[i][0] = (f32x4){0.f, 0.f, 0.f, 0.f}; o[i][1] = (f32x4){0.f, 0.f, 0.f, 0.f}; }
  char* sK = smem; float* sX = (float*)smem;
  const u16 *bkl[2], *bvl[2], *bkc[2], *bvc[2];
#pragma unroll
  for (int I = 0; I < 2; ++I) {
    const int u_ = (I * 4 + w) * 64 + lane; const int row_ = u_ >> 3, cp_ = u_ & 7;
    const int chk_ = cp_ ^ (row_ & 7), chv_ = cp_ ^ ((row_ >> 1) & 7);
    bkl[I] = Pb + (size_t)(kstart_l + row_) * PW + kcol + chk_ * 8;
    bvl[I] = VT + (size_t)(kvhead * 64 + row_) * GT + kstart_l + chv_ * 8;
    bkc[I] = (MODE == 0) ? ctxK + (size_t)row_ * 64 + chk_ * 8 : ctxK + (size_t)(chk_ >> 2) * 512 * 32 + (size_t)row_ * 32 + (chk_ & 3) * 8;
    bvc[I] = ctxV + (size_t)row_ * 512 + chv_ * 8;
  }
#define ATT_DMA1(I, J, SLOT) { \
      const int u_ = ((I) * 4 + w) * 64 + lane; \
      const u16 *kp_, *vp_; \
      if ((J) < nloc) { kp_ = bkl[I] + (size_t)(J) * (64 * PW); vp_ = bvl[I] + (J) * 64; } \
      else { const int jc_ = (J) - nloc; kp_ = bkc[I] + jc_ * ((MODE == 0) ? 4096 : 2048); vp_ = bvc[I] + jc_ * 64; } \
      __builtin_amdgcn_global_load_lds((const unsigned*)kp_, (__attribute__((address_space(3))) unsigned*)(sK + (SLOT) * 16384 + u_ * 16), 16, 0, 0); \
      __builtin_amdgcn_global_load_lds((const unsigned*)vp_, (__attribute__((address_space(3))) unsigned*)(sK + (SLOT) * 16384 + 8192 + u_ * 16), 16, 0, 0); }
#define dma_tile(J, SLOT) { ATT_DMA1(0, J, SLOT) ATT_DMA1(1, J, SLOT) }
  __syncthreads();
  const bool maskable = (MODE == 0) && samp;
  const int tqbase = t0 + qoff + fr;
  const int jbeg = half ? (ntile >> 1) : 0, jend = half ? ntile : (ntile >> 1);
  dma_tile(jbeg, 0);
  if (jbeg + 1 < jend) dma_tile(jbeg + 1, 1);
  __syncthreads();
  for (int tt = jbeg, par = 0; tt < jend; tt += 2, par ^= 2) {
    if (tt + 2 < jend) dma_tile(tt + 2, (par ^ 2));
    if (tt + 3 < jend) dma_tile(tt + 3, (par ^ 2) + 1);
    const char* kb0 = sK + par * 16384;
    attn_compute<MODE>(kb0, kb0 + 8192, qf, o, mfix, osum, scl, maskable && (tt < nloc), kstart_t + tt * 64 + fq * 4, tqbase, comp, fr, fq);
    if (tt + 1 < jend)
      attn_compute<MODE>(kb0 + 16384, kb0 + 16384 + 8192, qf, o, mfix, osum, scl, maskable && (tt + 1 < nloc), kstart_t + (tt + 1) * 64 + fq * 4, tqbase, comp, fr, fq);
    __syncthreads();
  }
#undef dma_tile
#undef ATT_DMA1
  {
    float4* mb = (float4*)smem1 + (size_t)tid * 10;
    if (half == 1) {
#pragma unroll
      for (int mt = 0; mt < 4; ++mt) { mb[mt * 2] = make_float4(o[mt][0][0], o[mt][0][1], o[mt][0][2], o[mt][0][3]); mb[mt * 2 + 1] = make_float4(o[mt][1][0], o[mt][1][1], o[mt][1][2], o[mt][1][3]); }
      mb[8] = make_float4(osum[0][0], osum[1][0], 0.f, 0.f);
    }
    __syncthreads();
    if (half == 0) {
      const float4 st = mb[8];
      osum[0][0] += st.x; osum[1][0] += st.y;
#pragma unroll
      for (int qt = 0; qt < 2; ++qt)
#pragma unroll
        for (int mt = 0; mt < 4; ++mt) { const float4 o1 = mb[mt * 2 + qt]; o[mt][qt][0] += o1.x; o[mt][qt][1] += o1.y; o[mt][qt][2] += o1.z; o[mt][qt][3] += o1.w; }
    }
  }
#pragma unroll
  for (int qt = 0; qt < 2; ++qt) {
    const float inv = 1.f / osum[qt][0];
#pragma unroll
    for (int mt = 0; mt < 4; ++mt) o[mt][qt] *= inv;
  }
  if (MODE == 0) {
    if (half == 0) {
#pragma unroll
    for (int qt = 0; qt < 2; ++qt) {
      u16* dst = MIX + (size_t)(ltq0 + qoff + qt * 16 + fr) * 1024 + 256 + h * 64;
#pragma unroll
      for (int mt = 0; mt < 4; ++mt) { uint2 v; v.x = pack2(o[mt][qt][0], o[mt][qt][1]); v.y = pack2(o[mt][qt][2], o[mt][qt][3]); *(uint2*)(dst + mt * 16 + fq * 4) = v; }
    }
    }
  } else {
    float* xb = sX + (w >> 1) * (32 * 68);
    if (comp == 1 && half == 0) {
#pragma unroll
      for (int qt = 0; qt < 2; ++qt)
#pragma unroll
        for (int mt = 0; mt < 4; ++mt) *(float4*)(xb + (qt * 16 + fr) * 68 + mt * 16 + fq * 4) = make_float4(o[mt][qt][0], o[mt][qt][1], o[mt][qt][2], o[mt][qt][3]);
    }
    __syncthreads();
    if (comp == 0 && half == 0) {
      float d1 = 0.f, d2 = 0.f;
      const float* dl = P.diff_lambda + l * 128;
#pragma unroll
      for (int i = 0; i < 32; ++i) { d1 += dl[i] * dl[32 + i]; d2 += dl[64 + i] * dl[96 + i]; }
      const float lam_init = 0.8f - 0.6f * __expf(-0.3f * (float)l);
      const float lam = __expf(d1) - __expf(d2) + lam_init;
#pragma unroll
      for (int qt = 0; qt < 2; ++qt) {
        float ss = 0.f;
#pragma unroll
        for (int mt = 0; mt < 4; ++mt) {
          float4 o2 = *(const float4*)(xb + (qt * 16 + fr) * 68 + mt * 16 + fq * 4);
          o[mt][qt][0] -= lam * o2.x; o[mt][qt][1] -= lam * o2.y; o[mt][qt][2] -= lam * o2.z; o[mt][qt][3] -= lam * o2.w;
#pragma unroll
          for (int r = 0; r < 4; ++r) ss += o[mt][qt][r] * o[mt][qt][r];
        }
        ss += __shfl_xor(ss, 16); ss += __shfl_xor(ss, 32);
        const float rs = rsqrtf(ss * (1.f / 64.f) + EPS) * (1.f - lam_init);
        u16* dst = MIX + (size_t)(ltq0 + qoff + qt * 16 + fr) * 1024 + 512 + h * 64;
#pragma unroll
        for (int mt = 0; mt < 4; ++mt) {
          float4 gn = *(const float4*)(P.diff_norm_g + l * 256 + h * 64 + mt * 16 + fq * 4);
          uint2 v; v.x = pack2(o[mt][qt][0] * rs * gn.x, o[mt][qt][1] * rs * gn.y); v.y = pack2(o[mt][qt][2] * rs * gn.z, o[mt][qt][3] * rs * gn.w);
          *(uint2*)(dst + mt * 16 + fq * 4) = v;
        }
      }
    }
  }
}

DI void gla_state_item(const Params& P, int l, int g, int stream, int chunk, int h, char* smem) {
  const int tid = get_tid(), lane = tid & 63, w = tid >> 6, fr = lane & 15, fq = lane >> 4;
  const u16* Pb = (const u16*)(P.ws + OFF_PB);
  const u16* VT = (const u16*)(P.ws + OFF_VT);
  const float* LF = (const float*)(P.ws + OFF_LF);
  u16* sV = (u16*)smem; float* sCf = (float*)(smem + 9216); float* sCb = (float*)(smem + 26624); u16* sKf = (u16*)(smem + 44032); u16* sKb = (u16*)(smem + 53248);
  const int ltok0 = chunk * 64;
  const int vh = (stream == 0 ? VH_RET : VH_HGRN) + h;
  __syncthreads();
#pragma unroll
  for (int i = 0; i < 2; ++i) { const int c = tid + 256 * i; const int dv = c >> 3, ch = c & 7; *(uint4*)((char*)sV + dv * 144 + ch * 16) = *(const uint4*)(VT + (size_t)(vh * 64 + dv) * GT + ltok0 + ch * 8); }
  if (stream == 0) {
    const float lgf = -__expf(P.ret_decay[(l * 2 + 0) * 4 + h]), lgb = -__expf(P.ret_decay[(l * 2 + 1) * 4 + h]);
#pragma unroll
    for (int i = 0; i < 16; ++i) { const int e = tid + 256 * i; const int s = e >> 6, d = e & 63; sCf[s * 68 + d] = (float)(s + 1) * lgf; sCb[s * 68 + d] = (float)(s + 1) * lgb; }
    __syncthreads();
  } else {
#pragma unroll
    for (int i = 0; i < 4; ++i) {
      const int c = tid + 256 * i; const int s = c >> 4, d4 = (c & 15) * 4;
      *(float4*)(sCf + s * 68 + d4) = *(const float4*)(LF + ((size_t)0 * GT + ltok0 + s) * 256 + h * 64 + d4);
      *(float4*)(sCb + s * 68 + d4) = *(const float4*)(LF + ((size_t)1 * GT + ltok0 + s) * 256 + h * 64 + d4);
    }
    __syncthreads();
    const int d = tid & 63, part = tid >> 6;
    float af = 0.f, ab = 0.f;
#pragma unroll
    for (int i = 0; i < 16; ++i) { const int s = part * 16 + i; af += sCf[s * 68 + d]; sCf[s * 68 + d] = af; ab += sCb[s * 68 + d]; sCb[s * 68 + d] = ab; }
    __syncthreads();
    float of = 0.f, ob = 0.f;
    for (int p = 0; p < part; ++p) { of += sCf[(p * 16 + 15) * 68 + d]; ob += sCb[(p * 16 + 15) * 68 + d]; }
    __syncthreads();
#pragma unroll
    for (int i = 0; i < 16; ++i) { const int s = part * 16 + i; sCf[s * 68 + d] += of; sCb[s * 68 + d] += ob; }
    __syncthreads();
  }
  {
    const int s = tid & 63, db = (tid >> 6) * 16;
    const u16* kp = Pb + (size_t)(ltok0 + s) * PW + PC_RK + h * 64 + db;
#pragma unroll
    for (int i = 0; i < 16; ++i) {
      const int d = db + i;
      const float cf = sCf[s * 68 + d], cfp = s > 0 ? sCf[(s - 1) * 68 + d] : 0.f, lastf = sCf[63 * 68 + d];
      const float cbv = sCb[s * 68 + d], cbp = s > 0 ? sCb[(s - 1) * 68 + d] : 0.f;
      float kf, kb;
      if (stream == 0) { kf = bf2f(kp[i]); kb = kf; } else { kf = 1.f - __expf(cf - cfp); kb = 1.f - __expf(cbv - cbp); }
      sKf[d * 72 + s] = f2bf(kf * __expf(lastf - cf));
      sKb[d * 72 + s] = f2bf(kb * __expf(cbp));
    }
  }
  __syncthreads();
  float* ST = (float*)(P.ws + OFF_ST); float* DEC = (float*)(P.ws + OFF_DEC);
#pragma unroll
  for (int dir = 0; dir < 2; ++dir) {
    const u16* sK = dir ? sKb : sKf;
    float* dst = ST + ((size_t)((stream * NCH + chunk) * 2 + dir) * 4 + h) * 4096;
#pragma unroll
    for (int nt = 0; nt < 4; ++nt) {
      f32x4 acc = (f32x4){0.f, 0.f, 0.f, 0.f};
#pragma unroll
      for (int ks = 0; ks < 2; ++ks) {
        bf16x8 a = *(const bf16x8*)((const char*)sV + (16 * w + fr) * 144 + (ks * 4 + fq) * 16);
        bf16x8 bb = *(const bf16x8*)((const char*)sK + (nt * 16 + fr) * 144 + (ks * 4 + fq) * 16);
        acc = MFMA(bb, a, acc);
      }
      *(float4*)(dst + (16 * w + fr) * 64 + nt * 16 + fq * 4) = make_float4(acc[0], acc[1], acc[2], acc[3]);
    }
  }
  if (tid < 128) {
    const int dir = tid >> 6, d = tid & 63;
    DEC[((size_t)((stream * NCH + chunk) * 2 + dir) * 4 + h) * 64 + d] = __expf((dir ? sCb : sCf)[63 * 68 + d]);
  }
}

DI void scan_phase(const Params& P, int l, int g) {
  const int tid = get_tid();
  const int nseq = (g == 0) ? 33 : 3;
  float* ST = (float*)(P.ws + OFF_ST); const float* DEC = (const float*)(P.ws + OFF_DEC);
  for (int it = get_vb(); it < nseq * 128; it += NVB) {
    const int sl = it >> 7, r = it & 127;
    const int stream = r >> 6, dir = (r >> 5) & 1, h = (r >> 3) & 3, slice = r & 7;
    const int e = slice * 512 + tid; const int dv = e >> 6, dk = e & 63;
    int chunk0, nch, b; bool samp;
    if (g == 0) { if (sl < 32) { samp = false; b = sl; chunk0 = sl * 4; nch = 4; } else { samp = true; b = 0; chunk0 = 128; nch = 64; } }
    else { samp = true; b = 1 + sl; chunk0 = sl * 64; nch = 64; }
    float s0v = 0.f, s1v = 0.f;
    if (samp) { const float* s0 = (stream == 0 ? P.state_ret : P.state_hgrn) + ((size_t)((b * 2 + l) * 2 + dir) * 4 + h) * 4096 + dk * 64 + dv; s0v = s0[0]; s1v = s0[4]; }
    for (int c0 = 0; c0 < nch; c0 += 8) {
      float u0[8], u1[8], d[8]; size_t idx[8];
#pragma unroll
      for (int q = 0; q < 8; ++q) {
        const int ci = c0 + q; const int cc = ci < nch ? ci : nch - 1; const int c = dir == 0 ? chunk0 + cc : chunk0 + nch - 1 - cc;
        const size_t base = (size_t)((stream * NCH + c) * 2 + dir) * 4 + h;
        idx[q] = base * 4096 + e; u0[q] = ST[idx[q]]; u1[q] = ST[idx[q] + 256]; d[q] = DEC[base * 64 + dk];
      }
#pragma unroll
      for (int q = 0; q < 8; ++q) { if (c0 + q < nch) { ST[idx[q]] = s0v; ST[idx[q] + 256] = s1v; s0v = d[q] * s0v + u0[q]; s1v = d[q] * s1v + u1[q]; } }
    }
    if (!samp) { float* so = P.out + (stream == 0 ? O_SRET : O_SHG) + ((size_t)((b * 2 + l) * 2 + dir) * 4 + h) * 4096 + dk * 64 + dv; so[0] = s0v; so[4] = s1v; }
  }
}

DI void gla_out_item(const Params& P, int l, int g, int stream, int chunk, int h, char* smem) {
  const int tid = get_tid(), lane = tid & 63, w = tid >> 6, fr = lane & 15, fq = lane >> 4;
  const u16* Pb = (const u16*)(P.ws + OFF_PB);
  const u16* VT = (const u16*)(P.ws + OFF_VT);
  const float* LF = (const float*)(P.ws + OFF_LF);
  const float* ST = (const float*)(P.ws + OFF_ST);
  u16* MIX = (u16*)(P.ws + OFF_HB);
  char* sQ = smem; char* sK = smem + 8192; float* sC = (float*)(smem + 16384); char* sV = smem + 33792; char* sS = smem + 43008;
  const int ltok0 = chunk * 64;
  const int qcol = (stream == 0 ? PC_RQ : PC_HQ) + h * 64, gcol = (stream == 0 ? PC_RG : PC_HG) + h * 64;
  const int vh = (stream == 0 ? VH_RET : VH_HGRN) + h;
  f32x4 of[4];
#pragma unroll
  for (int i = 0; i < 4; ++i) of[i] = (f32x4){0.f, 0.f, 0.f, 0.f};
#pragma unroll 1
  for (int pass = 0; pass < 2; ++pass) {
    __syncthreads();
#pragma unroll
    for (int i = 0; i < 2; ++i) {
      const int c = tid + 256 * i; const int row = c >> 3, ch = c & 7;
      const int tok = pass ? ltok0 + 63 - row : ltok0 + row;
      *(uint4*)(sQ + row * 128 + ((ch ^ (row & 7)) * 16)) = *(const uint4*)(Pb + (size_t)tok * PW + qcol + ch * 8);
      if (stream == 0) *(uint4*)(sK + row * 128 + ((ch ^ (row & 7)) * 16)) = *(const uint4*)(Pb + (size_t)tok * PW + PC_RK + h * 64 + ch * 8);
      uint4 vv = *(const uint4*)(VT + (size_t)(vh * 64 + row) * GT + ltok0 + ch * 8);
      if (pass) {
        uint4 t;
        t.x = (vv.w >> 16) | (vv.w << 16); t.y = (vv.z >> 16) | (vv.z << 16); t.z = (vv.y >> 16) | (vv.y << 16); t.w = (vv.x >> 16) | (vv.x << 16);
        *(uint4*)(sV + row * 144 + (7 - ch) * 16) = t;
      } else *(uint4*)(sV + row * 144 + ch * 16) = vv;
    }
    {
      const int dv = tid >> 2, part = tid & 3;
      const float* sp = ST + ((size_t)((stream * NCH + chunk) * 2 + pass) * 4 + h) * 4096 + dv * 64 + part * 16;
      float t[16];
#pragma unroll
      for (int i = 0; i < 4; ++i) { float4 f = *(const float4*)(sp + 4 * i); t[4 * i] = f.x; t[4 * i + 1] = f.y; t[4 * i + 2] = f.z; t[4 * i + 3] = f.w; }
#pragma unroll
      for (int hh = 0; hh < 2; ++hh) {
        uint4 o4; o4.x = pack2(t[8 * hh], t[8 * hh + 1]); o4.y = pack2(t[8 * hh + 2], t[8 * hh + 3]); o4.z = pack2(t[8 * hh + 4], t[8 * hh + 5]); o4.w = pack2(t[8 * hh + 6], t[8 * hh + 7]);
        const int ch = part * 2 + hh;
        *(uint4*)(sS + dv * 128 + ((ch ^ (dv & 7)) * 16)) = o4;
      }
    }
    if (stream == 0) {
      const float lg = -__expf(P.ret_decay[(l * 2 + pass) * 4 + h]);
#pragma unroll
      for (int i = 0; i < 16; ++i) { const int e = tid + 256 * i; const int s = e >> 6, d = e & 63; sC[s * 68 + d] = (float)(s + 1) * lg; }
      __syncthreads();
    } else {
#pragma unroll
      for (int i = 0; i < 4; ++i) {
        const int c = tid + 256 * i; const int row = c >> 4, d4 = (c & 15) * 4;
        const int tok = pass ? ltok0 + 63 - row : ltok0 + row;
        *(float4*)(sC + row * 68 + d4) = *(const float4*)(LF + ((size_t)pass * GT + tok) * 256 + h * 64 + d4);
      }
      __syncthreads();
      {
        const int row = tid >> 2, part = tid & 3;
        float t[16];
#pragma unroll
        for (int i = 0; i < 16; ++i) t[i] = 1.f - __expf(sC[row * 68 + part * 16 + i]);
#pragma unroll
        for (int hh = 0; hh < 2; ++hh) {
          uint4 o4; o4.x = pack2(t[8 * hh], t[8 * hh + 1]); o4.y = pack2(t[8 * hh + 2], t[8 * hh + 3]); o4.z = pack2(t[8 * hh + 4], t[8 * hh + 5]); o4.w = pack2(t[8 * hh + 6], t[8 * hh + 7]);
          const int ch = part * 2 + hh;
          *(uint4*)(sK + row * 128 + ((ch ^ (row & 7)) * 16)) = o4;
        }
      }
      __syncthreads();
      const int d = tid & 63, part = tid >> 6;
      float a = 0.f;
#pragma unroll
      for (int i = 0; i < 16; ++i) { const int s = part * 16 + i; a += sC[s * 68 + d]; sC[s * 68 + d] = a; }
      __syncthreads();
      float off = 0.f;
      for (int p = 0; p < part; ++p) off += sC[(p * 16 + 15) * 68 + d];
      __syncthreads();
#pragma unroll
      for (int i = 0; i < 16; ++i) { const int s = part * 16 + i; sC[s * 68 + d] += off; }
      __syncthreads();
    }
    const int j = pass ? 3 - w : w;
    const int rowq = 16 * j + fr;
    bf16x8 qB[2], qI[2];
    float cj[2][8];
#pragma unroll
    for (int ks = 0; ks < 2; ++ks) {
      const int d0 = ks * 32 + fq * 8;
      bf16x8 q8 = *(const bf16x8*)(sQ + rowq * 128 + (((ks * 4 + fq) ^ (rowq & 7)) * 16));
      float4 c0 = *(const float4*)(sC + rowq * 68 + d0), c1 = *(const float4*)(sC + rowq * 68 + d0 + 4);
      float cq[8] = {c0.x, c0.y, c0.z, c0.w, c1.x, c1.y, c1.z, c1.w};
      if (j > 0) {
        float4 j0 = *(const float4*)(sC + (16 * j - 1) * 68 + d0), j1 = *(const float4*)(sC + (16 * j - 1) * 68 + d0 + 4);
        cj[ks][0] = j0.x; cj[ks][1] = j0.y; cj[ks][2] = j0.z; cj[ks][3] = j0.w; cj[ks][4] = j1.x; cj[ks][5] = j1.y; cj[ks][6] = j1.z; cj[ks][7] = j1.w;
      } else {
#pragma unroll
        for (int e = 0; e < 8; ++e) cj[ks][e] = 0.f;
      }
      union { bf16x8 v; unsigned u[4]; } ub, ui;
#pragma unroll
      for (int e = 0; e < 4; ++e) {
        float q0 = bf2f((u16)q8[2 * e]), q1 = bf2f((u16)q8[2 * e + 1]);
        ub.u[e] = pack2(q0 * __expf(cq[2 * e] - cj[ks][2 * e]), q1 * __expf(cq[2 * e + 1] - cj[ks][2 * e + 1]));
        ui.u[e] = pack2(q0 * __expf(cq[2 * e]), q1 * __expf(cq[2 * e + 1]));
      }
      qB[ks] = ub.v; qI[ks] = ui.v;
    }
    f32x4 st[4];
#pragma unroll
    for (int i = 0; i < 4; ++i) {
      st[i] = (f32x4){0.f, 0.f, 0.f, 0.f};
      if (i <= j) {
        const int rowk = 16 * i + fr;
#pragma unroll
        for (int ks = 0; ks < 2; ++ks) {
          const int d0 = ks * 32 + fq * 8;
          bf16x8 k8 = *(const bf16x8*)(sK + rowk * 128 + (((ks * 4 + fq) ^ (rowk & 7)) * 16));
          float4 c0 = *(const float4*)(sC + rowk * 68 + d0), c1 = *(const float4*)(sC + rowk * 68 + d0 + 4);
          float ck[8] = {c0.x, c0.y, c0.z, c0.w, c1.x, c1.y, c1.z, c1.w};
          union { bf16x8 v; unsigned u[4]; } ua;
#pragma unroll
          for (int e = 0; e < 4; ++e) {
            float k0 = bf2f((u16)k8[2 * e]), k1 = bf2f((u16)k8[2 * e + 1]);
            ua.u[e] = pack2(k0 * __expf(fminf(cj[ks][2 * e] - ck[2 * e], 80.f)), k1 * __expf(fminf(cj[ks][2 * e + 1] - ck[2 * e + 1], 80.f)));
          }
          st[i] = MFMA(ua.v, qB[ks], st[i]);
        }
        if (i == j) {
#pragma unroll
          for (int r = 0; r < 4; ++r) if (fq * 4 + r > fr) st[i][r] = 0.f;
        }
      }
    }
    f32x4 o[4];
#pragma unroll
    for (int i = 0; i < 4; ++i) o[i] = (f32x4){0.f, 0.f, 0.f, 0.f};
#pragma unroll
    for (int kk = 0; kk < 2; ++kk) {
      if (2 * kk <= j) {
        union { bf16x8 v; unsigned u[4]; } pk;
        pk.u[0] = pack2(st[2 * kk][0], st[2 * kk][1]); pk.u[1] = pack2(st[2 * kk][2], st[2 * kk][3]);
        pk.u[2] = pack2(st[2 * kk + 1][0], st[2 * kk + 1][1]); pk.u[3] = pack2(st[2 * kk + 1][2], st[2 * kk + 1][3]);
#pragma unroll
        for (int mt = 0; mt < 4; ++mt) {
          s16x4 lo = *(const s16x4*)(sV + (mt * 16 + fr) * 144 + (kk * 32 + fq * 4) * 2);
          s16x4 hi = *(const s16x4*)(sV + (mt * 16 + fr) * 144 + (kk * 32 + 16 + fq * 4) * 2);
          bf16x8 a = __builtin_shufflevector(lo, hi, 0, 1, 2, 3, 4, 5, 6, 7);
          o[mt] = MFMA(a, pk.v, o[mt]);
        }
      }
    }
#pragma unroll
    for (int ks = 0; ks < 2; ++ks)
#pragma unroll
      for (int mt = 0; mt < 4; ++mt) {
        const int rs = mt * 16 + fr;
        bf16x8 a = *(const bf16x8*)(sS + rs * 128 + (((ks * 4 + fq) ^ (rs & 7)) * 16));
        o[mt] = MFMA(a, qI[ks], o[mt]);
      }
    if (pass == 0) {
#pragma unroll
      for (int mt = 0; mt < 4; ++mt) of[mt] = o[mt];
    } else {
      const int srcl = (lane & 48) | (15 - fr);
#pragma unroll
      for (int mt = 0; mt < 4; ++mt)
#pragma unroll
        for (int r = 0; r < 4; ++r) of[mt][r] += __shfl(o[mt][r], srcl);
    }
  }
  const int tok = ltok0 + 16 * w + fr;
  float ss = 0.f;
#pragma unroll
  for (int mt = 0; mt < 4; ++mt)
#pragma unroll
    for (int r = 0; r < 4; ++r) ss += of[mt][r] * of[mt][r];
  ss += __shfl_xor(ss, 16); ss += __shfl_xor(ss, 32);
  const float rs = rsqrtf(ss * (1.f / 64.f) + EPS);
  const float* gnp = (stream == 0 ? P.ret_norm_g : P.hgrn_norm_g) + l * 256 + h * 64;
  u16* dst = MIX + (size_t)tok * 1024 + (stream == 0 ? 0 : 768) + h * 64;
  float4 gnv[4]; uint2 gtv[4];
#pragma unroll
  for (int mt = 0; mt < 4; ++mt) { const int dv = mt * 16 + fq * 4; gnv[mt] = *(const float4*)(gnp + dv); gtv[mt] = *(const uint2*)(Pb + (size_t)tok * PW + gcol + dv); }
#pragma unroll
  for (int mt = 0; mt < 4; ++mt) {
    const int dv = mt * 16 + fq * 4;
    const float4 gn = gnv[mt]; const uint2 gt = gtv[mt];
    float g0 = bf2f((u16)(gt.x & 0xffff)), g1 = bf2f((u16)(gt.x >> 16)), g2 = bf2f((u16)(gt.y & 0xffff)), g3 = bf2f((u16)(gt.y >> 16));
    uint2 v; v.x = pack2(of[mt][0] * rs * gn.x * g0, of[mt][1] * rs * gn.y * g1); v.y = pack2(of[mt][2] * rs * gn.z * g2, of[mt][3] * rs * gn.w * g3);
    *(uint2*)(dst + dv) = v;
  }
}

DI void mix1_phase(const Params& P, int l, int g, char* smem, char* smem1) {
  constexpr int N_DIFF = 768, N_WIN = 384, N_ST = 2 * NCH * 4;
  int bid = blockIdx.x; asm volatile("" : "+s"(bid));
  for (int it = bid; it < N_DIFF; it += gridDim.x) attn_item<1>(P, l, g, it, smem, smem1);
  for (int it = bid; it < N_WIN; it += gridDim.x) attn_item<0>(P, l, g, it, smem, smem1);
  for (int it = get_vb(); it < N_ST; it += NVB) { int stream = it / (NCH * 4); int rr = it % (NCH * 4); gla_state_item(P, l, g, stream, rr >> 2, rr & 3, smem); }
}
DI void mix3_phase(const Params& P, int l, int g, char* smem) {
  for (int it = get_vb(); it < 2 * NCH * 4; it += NVB) { int stream = it / (NCH * 4); int rr = it % (NCH * 4); gla_out_item(P, l, g, stream, rr >> 2, rr & 3, smem); }
}

#define XB_TMO      128
#define XB_XCNT(j)  (256  + 64 * (j))
#define XB_XSUB(j)  (1280 + 64 * (j))
#define XB_XGEN(j)  (2304 + 64 * (j))
#define XB_TOP      3328
#define XB_TOPGEN   3392
#define XCD_BAR_WORDS 3456
#define XB_SPIN_CAP (1u << 22)
#define LAS __attribute__((address_space(3)))
DI unsigned xb_ld(unsigned* p) { return __hip_atomic_load(p, __ATOMIC_RELAXED, __HIP_MEMORY_SCOPE_AGENT); }
DI unsigned xb_add(unsigned* p, unsigned v) { return __hip_atomic_fetch_add(p, v, __ATOMIC_RELAXED, __HIP_MEMORY_SCOPE_AGENT); }
DI unsigned xb_xcc_id() { return (unsigned)__builtin_amdgcn_s_getreg((3 << 11) | 20) & 0xFu; }
#define XB_SPIN(cond, bar) do { unsigned _sp = 0; while (cond) { __builtin_amdgcn_s_sleep(1); \
    if ((++_sp & 255u) == 0u) { if (xb_ld(&(bar)[XB_TMO])) break; if (_sp > XB_SPIN_CAP) { atomicAdd(&(bar)[XB_TMO], 1u); break; } } } } while (0)
struct XcdBarrier { unsigned* bar; unsigned x; volatile LAS unsigned* st; };
DI XcdBarrier xcd_barrier_post(unsigned* bar, volatile LAS unsigned* st) {
  XcdBarrier b; b.bar = bar; b.x = xb_xcc_id(); b.st = st;
  if (threadIdx.x == 0) (void)xb_add(&bar[XB_XCNT(b.x)], 1u);
  return b;
}
DI void xcd_barrier_complete(unsigned* bar, unsigned x, unsigned& nloc, unsigned& nx) {
  const unsigned G = gridDim.x * gridDim.y * gridDim.z;
  unsigned sum, cnt, mine, sp = 0u;
  for (;;) {
    sum = 0u; cnt = 0u; mine = 0u;
#pragma unroll
    for (unsigned j = 0; j < 16; ++j) { const unsigned c = xb_ld(&bar[XB_XCNT(j)]); sum += c; cnt += (c > 0u) ? 1u : 0u; mine = (j == x) ? c : mine; }
    if (sum == G) break;
    __builtin_amdgcn_s_sleep(1);
    if ((++sp & 255u) == 0u) { if (xb_ld(&bar[XB_TMO])) break; if (sp > XB_SPIN_CAP) { atomicAdd(&bar[XB_TMO], 1u); break; } }
  }
  nloc = mine > 0u ? mine : 1u; nx = cnt > 0u ? cnt : 1u;
}
DI void xcd_barrier(const XcdBarrier& b) {
  asm volatile("s_waitcnt vmcnt(0)" ::: "memory");
  __syncthreads();
  if (threadIdx.x == 0) {
    unsigned* bar = b.bar;
    __builtin_amdgcn_s_waitcnt(0);
    unsigned nloc = b.st[0], nx = b.st[1];
    if (nloc == 0u) { xcd_barrier_complete(bar, b.x, nloc, nx); b.st[0] = nloc; b.st[1] = nx; }
    const unsigned old = xb_add(&bar[XB_XSUB(b.x)], 1u);
    const unsigned gen = old / nloc;
    if (old + 1u == (gen + 1u) * nloc) {
      __builtin_amdgcn_fence(__ATOMIC_RELEASE, "agent");
      asm volatile("s_waitcnt vmcnt(0)" ::: "memory");
      const unsigned og = xb_add(&bar[XB_TOP], 1u);
      const unsigned tg = og / nx;
      if (og + 1u == (tg + 1u) * nx) xb_add(&bar[XB_TOPGEN], 1u);
      else XB_SPIN(xb_ld(&bar[XB_TOPGEN]) == tg, bar);
      __builtin_amdgcn_fence(__ATOMIC_ACQUIRE, "agent");
      xb_add(&bar[XB_XGEN(b.x)], 1u);
      asm volatile("s_waitcnt vmcnt(0)" ::: "memory");
    } else {
      XB_SPIN(xb_ld(&bar[XB_XGEN(b.x)]) == gen, bar);
      __builtin_amdgcn_fence(__ATOMIC_ACQUIRE, "agent");
      asm volatile("s_waitcnt vmcnt(0)" ::: "memory");
    }
  }
  __syncthreads();
}

constexpr int DYN_LDS = 131072 + 64 + 12288;
__global__ void __launch_bounds__(512, 2) hybrid_megakernel(Params P) {
  extern __shared__ __attribute__((aligned(16))) unsigned char dyn[];
  cg::grid_group grid = cg::this_grid();
  volatile LAS unsigned* xbw = (volatile LAS unsigned*)((LAS unsigned char*)dyn + 131072);
  if (threadIdx.x == 0) { xbw[0] = 0u; xbw[1] = 0u; }
  __syncthreads();
  XcdBarrier xb = xcd_barrier_post((unsigned*)P.ws, xbw);
  char* smem = (char*)dyn + (threadIdx.x >> 8) * 65536;
  pg8::PG8_LAS_T* glds = (pg8::PG8_LAS_T*)dyn;
  prep_phase(P, smem);
  grid.sync();
  const __attribute__((address_space(3))) f32x2_t* ltab = (const __attribute__((address_space(3))) f32x2_t*)((LAS unsigned char*)dyn + 131072 + 64);
  {
    __attribute__((address_space(3))) f32x2_t* lt = (__attribute__((address_space(3))) f32x2_t*)((LAS unsigned char*)dyn + 131072 + 64);
    const f32x2_t* gt = (const f32x2_t*)(P.ws + OFF_ROPEA);
    for (int i = threadIdx.x; i < 1536; i += 512) lt[i] = gt[i];
    __syncthreads();
  }
  for (int l = 0; l < 2; ++l) {
    for (int g = 0; g < NGROUP; ++g) {
      norm_phase(P, l, g, 0, !(l == 0 && g == 0));
      xcd_barrier(xb);
      { EpiIn E; E.P = &P; E.l = l; E.g = g; E.ltab = ltab; gemm_run(glds, (const u16*)(P.ws + OFF_HB), (const u16*)(P.ws + OFF_WIN) + (size_t)l * 3584 * 1024, 3584, 1024, E); }
      xcd_barrier(xb);
      mix1_phase(P, l, g, smem, (char*)dyn + 65536 + (threadIdx.x >> 9) * 16);
      xcd_barrier(xb);
      scan_phase(P, l, g);
      xcd_barrier(xb);
      mix3_phase(P, l, g, smem);
      xcd_barrier(xb);
      { EpiResid<0> E; E.P = &P; E.l = l; E.g = g; gemm_run(glds, (const u16*)(P.ws + OFF_HB), (const u16*)(P.ws + OFF_WOUT) + (size_t)l * 1024 * 1024, 1024, 1024, E); }
      xcd_barrier(xb);
      norm_phase(P, l, g, 1, false);
      xcd_barrier(xb);
      { EpiSwiglu E; E.P = &P; gemm_run(glds, (const u16*)(P.ws + OFF_HB), (const u16*)(P.ws + OFF_WFI) + (size_t)l * 5632 * 1024, 5632, 1024, E); }
      xcd_barrier(xb);
      { EpiResid<1> E; E.P = &P; E.l = l; E.g = g; gemm_run(glds, (const u16*)(P.ws + OFF_PB), (const u16*)(P.ws + OFF_WFO) + (size_t)l * 1024 * 2816, 1024, 2816, E); }
      if (l == 0) prep_l1_half(P, smem, g);
    }
  }
}

extern "C" void kernel_launch(void* const* d_in, const int* in_sizes, int n_in, void* d_out, int out_size, void* d_ws, size_t ws_size,
                              hipStream_t stream) {
  static int grid_blocks = 0;
  if (!grid_blocks) {
    int dev = 0, cus = 0, per_cu = 0;
    hipGetDevice(&dev);
    hipDeviceGetAttribute(&cus, hipDeviceAttributeMultiprocessorCount, dev);
    if (hipFuncSetAttribute((const void*)hybrid_megakernel, hipFuncAttributeMaxDynamicSharedMemorySize, DYN_LDS) != hipSuccess) fprintf(stderr, "hipFuncSetAttribute failed\n");
    hipOccupancyMaxActiveBlocksPerMultiprocessor(&per_cu, (const void*)hybrid_megakernel, 512, DYN_LDS);
    if (per_cu > 1) per_cu = 1;
    if (per_cu < 1) { fprintf(stderr, "occupancy query returned %d\n", per_cu); per_cu = 1; }
    grid_blocks = cus * per_cu;
  }
  if (ws_size < WS_TOTAL) fprintf(stderr, "workspace too small: %zu < %zu\n", ws_size, (size_t)WS_TOTAL);
  Params p{};
  const float** pp = (const float**)&p;
  for (int i = 0; i < 29; ++i) pp[i] = (const float*)d_in[i];
  p.out = (float*)d_out;
  p.ws = (char*)d_ws;
  hipMemsetAsync(d_ws, 0, 16384, stream);
  void* args[] = {&p};
  hipError_t e = hipLaunchCooperativeKernel((void*)hybrid_megakernel, dim3(grid_blocks), dim3(512), args, DYN_LDS, stream);
  if (e != hipSuccess) fprintf(stderr, "cooperative launch failed: %s (grid %d)\n", hipGetErrorString(e), grid_blocks);
}
```
